# Optimizing an MI355X kernel written in HIP

```python
import math
import jax, jax.numpy as jnp
from jax import lax
import numpy as np

D_MODEL = 1024
BATCH = 2
SEQ = 8192
DEPTH = 4

CHUNK = 64
N_HEADS = 16
HEAD_DIM = 64
IDX_HEADS = 8
IDX_DIM = 64
TOPK_MAX = 256
A_QBLOCK = 64
B_QBLOCK = 128
ROPE_THETA = 10000.0
D_FF = 2816
N_EXPERTS = 8
TOP_K = 2
RMS_EPS = 1e-6

kernel_name = "yoco_dsa_fox_moe_trunk"


def rms_norm(x, g):
    xf = x.astype(jnp.float32)
    y = xf * lax.rsqrt(jnp.mean(xf * xf, axis=-1, keepdims=True) + RMS_EPS)
    return (y * g.astype(jnp.float32)).astype(x.dtype)


def rope_tables(seq_len, dim):
    pos = jnp.arange(seq_len, dtype=jnp.float32)
    inv_freq = 1.0 / (ROPE_THETA ** (jnp.arange(0, dim, 2, dtype=jnp.float32) / dim))
    ang = pos[:, None] * inv_freq[None, :]
    return jnp.cos(ang), jnp.sin(ang)


def apply_rope(x, cos, sin):
    half = x.shape[-1] // 2
    c = cos[None, :, None, :].astype(x.dtype)
    s = sin[None, :, None, :].astype(x.dtype)
    x1, x2 = x[..., :half], x[..., half:]
    return jnp.concatenate([x1 * c - x2 * s, x2 * c + x1 * s], axis=-1)


def to_blocks(a, qb):
    b, s = a.shape[0], a.shape[1]
    return a.reshape(b, s // qb, qb, *a.shape[2:]).swapaxes(0, 1)


def from_blocks(a):
    a = a.swapaxes(0, 1)
    return a.reshape(a.shape[0], a.shape[1] * a.shape[2], *a.shape[3:])


def swiglu(x, w_gate_up, w_down):
    gu = x @ w_gate_up
    g, u = jnp.split(gu, 2, axis=-1)
    return (jax.nn.silu(g) * u) @ w_down


def moe_swiglu(x, w_router, w_gate_up, w_down):
    logits = (x @ w_router).astype(jnp.float32)
    top_vals, top_idx = lax.top_k(logits, TOP_K)
    gates = jax.nn.softmax(top_vals, axis=-1)
    combine = jnp.sum(jax.nn.one_hot(top_idx, N_EXPERTS, dtype=jnp.float32)
                      * gates[..., None], axis=-2).astype(x.dtype)
    out = jnp.zeros_like(x)
    for e in range(N_EXPERTS):
        out = out + combine[..., e:e + 1] * swiglu(x, w_gate_up[e], w_down[e])
    return out


def mixer_a(hn, w_in, w_out, cos, sin):
    B, S, _ = hn.shape
    hd = N_HEADS * HEAD_DIM
    splits = [hd, 2 * hd, 3 * hd, 3 * hd + IDX_HEADS * IDX_DIM,
              3 * hd + IDX_HEADS * IDX_DIM + IDX_DIM]
    p = hn @ w_in
    q, k, v, qi, ki, wi = jnp.split(p, splits, axis=-1)
    q = apply_rope(q.reshape(B, S, N_HEADS, HEAD_DIM), cos, sin)
    k = apply_rope(k.reshape(B, S, N_HEADS, HEAD_DIM), cos, sin)
    v = v.reshape(B, S, N_HEADS, HEAD_DIM)
    qi = apply_rope(qi.reshape(B, S, IDX_HEADS, IDX_DIM), cos, sin)
    ki = apply_rope(ki[:, :, None, :], cos, sin)[:, :, 0, :]
    wi = wi * (IDX_HEADS ** -0.5)
    k_sel = min(TOPK_MAX, S // 4)
    scale = HEAD_DIM ** -0.5
    key_pos = jnp.arange(S)

    def block(args):
        qb, qib, wib, b0 = args
        t = b0 * A_QBLOCK + jnp.arange(A_QBLOCK)
        limit = (t // CHUNK + 1) * CHUNK
        visible = key_pos[None, :] < limit[:, None]
        sc = jnp.einsum('bqhd,bsd->bqhs', qib, ki).astype(jnp.float32)
        idx_score = jnp.einsum('bqhs,bqh->bqs', jax.nn.relu(sc), wib.astype(jnp.float32))
        idx_score = jnp.where(visible[None], idx_score, -jnp.inf)
        _, sel = lax.top_k(idx_score, k_sel)
        valid = sel < limit[None, :, None]
        kg = jax.vmap(lambda a, i: a[i])(k, sel)
        vg = jax.vmap(lambda a, i: a[i])(v, sel)
        logits = jnp.einsum('bqhd,bqkhd->bqhk', qb, kg).astype(jnp.float32) * scale
        logits = jnp.where(valid[:, :, None, :], logits, -jnp.inf)
        probs = jax.nn.softmax(logits, axis=-1).astype(qb.dtype)
        return jnp.einsum('bqhk,bqkhd->bqhd', probs, vg)

    nb = S // A_QBLOCK
    o = lax.map(block, (to_blocks(q, A_QBLOCK), to_blocks(qi, A_QBLOCK),
                        to_blocks(wi, A_QBLOCK), jnp.arange(nb)))
    o = from_blocks(o).reshape(B, S, N_HEADS * HEAD_DIM)
    return o @ w_out


def shared_kv(h, g, w_kv, b_f):
    B, S, _ = h.shape
    hd = N_HEADS * HEAD_DIM
    hn = rms_norm(h, g)
    p = hn @ w_kv
    k, v, f_logit = jnp.split(p, [hd, 2 * hd], axis=-1)
    k = k.reshape(B, S, N_HEADS, HEAD_DIM)
    v = v.reshape(B, S, N_HEADS, HEAD_DIM)
    log_f = jax.nn.log_sigmoid(f_logit.astype(jnp.float32) + b_f.astype(jnp.float32))
    cum_log_f = jnp.cumsum(log_f, axis=1)
    return k, v, cum_log_f


def mixer_b(hn, w_q, w_out, k, v, cum_log_f):
    B, S, _ = hn.shape
    q = (hn @ w_q).reshape(B, S, N_HEADS, HEAD_DIM)
    scale = HEAD_DIM ** -0.5
    f_keys = cum_log_f.transpose(0, 2, 1)
    key_pos = jnp.arange(S)

    def block(args):
        qb, fq, b0 = args
        t = b0 * B_QBLOCK + jnp.arange(B_QBLOCK)
        causal = key_pos[None, :] <= t[:, None]
        logits = jnp.einsum('bqhd,bshd->bhqs', qb, k).astype(jnp.float32) * scale
        logits = logits + fq.transpose(0, 2, 1)[..., None] - f_keys[:, :, None, :]
        logits = jnp.where(causal[None, None], logits, -jnp.inf)
        probs = jax.nn.softmax(logits, axis=-1).astype(qb.dtype)
        return jnp.einsum('bhqs,bshd->bqhd', probs, v)

    nb = S // B_QBLOCK
    o = lax.map(block, (to_blocks(q, B_QBLOCK), to_blocks(cum_log_f, B_QBLOCK),
                        jnp.arange(nb)))
    o = from_blocks(o).reshape(B, S, N_HEADS * HEAD_DIM)
    return o @ w_out


def setup_inputs(seed: int = 0) -> dict:
    key = jax.random.key(seed)
    ks = jax.random.split(key, 20)
    n_a = DEPTH // 2
    n_b = DEPTH - n_a
    n_dense = (DEPTH + 1) // 2
    n_moe = DEPTH // 2
    hd = N_HEADS * HEAD_DIM
    a_in_width = 3 * hd + IDX_HEADS * IDX_DIM + IDX_DIM + IDX_HEADS
    out_scale = (2.0 * DEPTH) ** -0.5

    def w(k, shape, fan_in, extra=1.0):
        return jax.random.normal(k, shape, jnp.float32) * (fan_in ** -0.5) * extra

    def gain(k, shape):
        return 1.0 + 0.02 * jax.random.normal(k, shape, jnp.float32)

    return {
        "x": jax.random.normal(ks[0], (BATCH, SEQ, D_MODEL), jnp.float32),
        "a_norm": gain(ks[1], (n_a, D_MODEL)),
        "a_w_in": w(ks[2], (n_a, D_MODEL, a_in_width), D_MODEL),
        "a_w_out": w(ks[3], (n_a, hd, D_MODEL), hd, out_scale),
        "kv_norm": gain(ks[4], (D_MODEL,)),
        "w_kv": w(ks[5], (D_MODEL, 2 * hd + N_HEADS), D_MODEL),
        "b_f": 3.0 + 0.5 * jax.random.normal(ks[6], (N_HEADS,), jnp.float32),
        "b_norm": gain(ks[7], (n_b, D_MODEL)),
        "b_w_q": w(ks[8], (n_b, D_MODEL, hd), D_MODEL),
        "b_w_out": w(ks[9], (n_b, hd, D_MODEL), hd, out_scale),
        "ffn_norm": gain(ks[10], (DEPTH, D_MODEL)),
        "dense_w_gate_up": w(ks[11], (n_dense, D_MODEL, 2 * D_FF), D_MODEL),
        "dense_w_down": w(ks[12], (n_dense, D_FF, D_MODEL), D_FF, out_scale),
        "moe_router": w(ks[13], (n_moe, D_MODEL, N_EXPERTS), D_MODEL),
        "moe_w_gate_up": w(ks[14], (n_moe, N_EXPERTS, D_MODEL, 2 * D_FF), D_MODEL),
        "moe_w_down": w(ks[15], (n_moe, N_EXPERTS, D_FF, D_MODEL), D_FF, out_scale),
        "final_norm": gain(ks[16], (D_MODEL,)),
    }


def reference(x, a_norm, a_w_in, a_w_out, kv_norm, w_kv, b_f, b_norm, b_w_q,
              b_w_out, ffn_norm, dense_w_gate_up, dense_w_down, moe_router,
              moe_w_gate_up, moe_w_down, final_norm):
    S = x.shape[1]
    n_a = DEPTH // 2
    cos, sin = rope_tables(S, HEAD_DIM)
    h = x
    k_sh = v_sh = f_sh = None
    for i in range(DEPTH):
        if i < n_a:
            h = h + mixer_a(rms_norm(h, a_norm[i]), a_w_in[i], a_w_out[i], cos, sin)
        else:
            if i == n_a:
                k_sh, v_sh, f_sh = shared_kv(h, kv_norm, w_kv, b_f)
            j = i - n_a
            h = h + mixer_b(rms_norm(h, b_norm[j]), b_w_q[j], b_w_out[j], k_sh, v_sh, f_sh)
        hn = rms_norm(h, ffn_norm[i])
        if i % 2 == 0:
            h = h + swiglu(hn, dense_w_gate_up[i // 2], dense_w_down[i // 2])
        else:
            h = h + moe_swiglu(hn, moe_router[i // 2], moe_w_gate_up[i // 2], moe_w_down[i // 2])
    return rms_norm(h, final_norm)
```

```cpp
#include <hip/hip_runtime.h>
#include <cstdio>
#include <cstdint>
namespace pg8 {
#define PG8_LAS __attribute__((address_space(3)))
typedef unsigned short bf16_t;
typedef short bf16x8 __attribute__((ext_vector_type(8)));
typedef float f32x4 __attribute__((ext_vector_type(4)));
typedef unsigned u32x4 __attribute__((ext_vector_type(4)));
constexpr int BM = 256, BK = 64, HALF = 128, HTB = HALF * BK * 2  , STAGE_BYTES = 8 * HTB, NXCD = 8, WGM = 8;

__host__ __device__ __forceinline__ int lds_byte(int r, int c) { const int st = (r >> 4) * 2 + (c >> 5), rr = r & 15, cc = c & 31, ob = rr * 64 + cc * 2; return st * 1024 + (ob ^ (((ob >> 9) & 1) << 5)); }
__host__ __device__ __forceinline__ void stage_rc(int b, int& R, int& C) { const int st = b / 1024, sb = b % 1024, swz = sb ^ (((sb >> 9) & 1) << 5); R = (st >> 1) * 16 + swz / 64; C = (st & 1) * 32 + (swz % 64) / 2; }
__host__ __device__ __forceinline__ int perm32(int rho) { const int n = rho >> 4, i = rho & 15; return 8 * (i >> 2) + 4 * n + (i & 3); }

struct Unit { int pm, pn; };
struct Gemm { const bf16_t* A; const bf16_t* Bt; int M, N, K; };

struct StaticOrder {
    int nM, nN, nwg, G, c;
    __host__ __device__ void init(int M, int N, int G_, int c_) { nM = M / BM; nN = N / BM; nwg = nM * nN; G = G_; c = c_; }
    __host__ __device__ bool next(int i, Unit& u) const {
        const long L = (long)i * G + c; if (L >= nwg) return false;
        int wgid = (int)L; { const int q = nwg / NXCD, r = nwg % NXCD, xcd = wgid % NXCD, off = wgid / NXCD; wgid = (xcd < r ? xcd * (q + 1) : r * (q + 1) + (xcd - r) * q) + off; }
        const int nig = WGM * nN, gid = wgid / nig, fm = gid * WGM, gsz = (nM - fm) < WGM ? (nM - fm) : WGM;
        u.pm = fm + ((wgid % nig) % gsz); u.pn = (wgid % nig) / gsz; return true;
    }
    __device__ __forceinline__ void a_ready(const Unit&) const {}
    __device__ __forceinline__ void done(const Unit&) const {}
};

typedef float f32x2 __attribute__((ext_vector_type(2)));
typedef unsigned u32x2 __attribute__((ext_vector_type(2)));
__device__ __forceinline__ unsigned pkbf(float lo, float hi) { typedef __bf16 b2 __attribute__((ext_vector_type(2))); f32x2 v = {lo, hi}; b2 b = __builtin_convertvector(v, b2); return __builtin_bit_cast(unsigned, b); }
constexpr float RMS_EPS_F = 1e-6f;
constexpr int DMODEL = 1024, SSQ_PARTS = 16;
__device__ __forceinline__ void rstd_rows(const float* ssq, int row0, int fq, float (&rs)[2][4]) {
#pragma unroll
    for (int ai = 0; ai < 2; ++ai)
#pragma unroll
        for (int m = 0; m < 4; ++m) { const f32x4 p = *(const f32x4*)(ssq + (size_t)(row0 + ai * HALF + m * 16) * SSQ_PARTS + 4 * fq);
            float s = (p[0] + p[1]) + (p[2] + p[3]); s += __shfl_xor(s, 16); s += __shfl_xor(s, 32);
            rs[ai][m] = 1.0f / sqrtf(s * (1.0f / DMODEL) + RMS_EPS_F); }
}
struct EpiRes {
    static constexpr bool PERM = true, AFTER_DRAIN = false;
    const float* base; float* out; bf16_t* hb; float* ssq;
    __device__ __forceinline__ void operator()(const f32x4 (&acc)[2][2][4][2], const Unit& u, int wr, int wc, int fr, int fq) const {
        const int row0 = u.pm * BM + wr * 64 + fr, col0 = u.pn * BM + wc * 32 + 8 * fq;
#pragma unroll
        for (int ai = 0; ai < 2; ++ai)
#pragma unroll
            for (int m = 0; m < 4; ++m) { const int row = row0 + ai * HALF + m * 16; float sq = 0.f;
#pragma unroll
                for (int bj = 0; bj < 2; ++bj) { const size_t off = (size_t)row * DMODEL + col0 + bj * HALF;
                    const f32x4 v0 = acc[ai][bj][m][0] + *(const f32x4*)(base + off), v1 = acc[ai][bj][m][1] + *(const f32x4*)(base + off + 4);
                    *(f32x4*)(out + off) = v0; *(f32x4*)(out + off + 4) = v1;
                    u32x4 w; w.x = pkbf(v0[0], v0[1]); w.y = pkbf(v0[2], v0[3]); w.z = pkbf(v1[0], v1[1]); w.w = pkbf(v1[2], v1[3]);
                    *(u32x4*)(hb + off) = w;
                    sq += (v0[0] * v0[0] + v0[1] * v0[1]) + (v0[2] * v0[2] + v0[3] * v0[3]) + (v1[0] * v1[0] + v1[1] * v1[1]) + (v1[2] * v1[2] + v1[3] * v1[3]); }
                sq += __shfl_xor(sq, 16); sq += __shfl_xor(sq, 32);
                if (fq == 0) ssq[(size_t)row * SSQ_PARTS + u.pn * 4 + wc] = sq; }
    }
};
struct EpiAin {
    static constexpr bool PERM = true, AFTER_DRAIN = false;
    bf16_t *Q, *K, *V, *QI, *KI; float* WI; const float* ssq; const float* cosT; const float* sinT; float qscale;
    __device__ __forceinline__ void operator()(const f32x4 (&acc)[2][2][4][2], const Unit& u, int wr, int wc, int fr, int fq) const {
        const int row0 = u.pm * BM + wr * 64 + fr; float rs[2][4]; rstd_rows(ssq, row0, fq, rs);
        const int pn = u.pn;
        if (pn >= 8 && pn < 12) {
            const int col0 = (pn - 8) * BM + wc * 32 + 8 * fq;
#pragma unroll
            for (int ai = 0; ai < 2; ++ai)
#pragma unroll
                for (int m = 0; m < 4; ++m) { const int row = row0 + ai * HALF + m * 16; const float r = rs[ai][m];
#pragma unroll
                    for (int bj = 0; bj < 2; ++bj) { const f32x4 v0 = acc[ai][bj][m][0] * r, v1 = acc[ai][bj][m][1] * r;
                        u32x4 w; w.x = pkbf(v0[0], v0[1]); w.y = pkbf(v0[2], v0[3]); w.z = pkbf(v1[0], v1[1]); w.w = pkbf(v1[2], v1[3]);
                        *(u32x4*)(V + (size_t)row * DMODEL + col0 + bj * HALF) = w; } }
            return;
        }
        bf16_t* dst; int pitch, colbase; float sc = 1.f;
        if (pn < 4) { dst = Q; pitch = DMODEL; colbase = pn * BM; sc = qscale; }
        else if (pn < 8) { dst = K; pitch = DMODEL; colbase = (pn - 4) * BM; }
        else if (pn < 14) { dst = QI; pitch = 512; colbase = (pn - 12) * BM; }
        else { dst = KI; pitch = 64; colbase = 0; }
        const int g = 4 * (wc & 1) + fq;
#pragma unroll
        for (int ai = 0; ai < 2; ++ai)
#pragma unroll
            for (int m = 0; m < 4; ++m) { const int row = row0 + ai * HALF + m * 16; const float r = rs[ai][m] * sc; const int t = row & 8191;
                const f32x4 c4 = *(const f32x4*)(cosT + t * 32 + 4 * g), s4 = *(const f32x4*)(sinT + t * 32 + 4 * g);
#pragma unroll
                for (int bj = 0; bj < 2; ++bj) { const int cit = bj * HALF + wc * 32;
                    const f32x4 x1 = acc[ai][bj][m][0] * r, x2 = acc[ai][bj][m][1] * r;
                    if (pn == 14) {
                        if (cit == 64 && fq == 0) { const float ws = 0.35355339059327373f; *(f32x4*)(WI + (size_t)row * 8) = acc[ai][bj][m][0] * (rs[ai][m] * ws); *(f32x4*)(WI + (size_t)row * 8 + 4) = acc[ai][bj][m][1] * (rs[ai][m] * ws); }
                        if (cit >= 64) continue;
                    }
                    const f32x4 y1 = x1 * c4 - x2 * s4, y2 = x2 * c4 + x1 * s4;
                    bf16_t* p = dst + (size_t)row * pitch + colbase + (cit & ~63) + 4 * g;
                    u32x2 w1, w2; w1.x = pkbf(y1[0], y1[1]); w1.y = pkbf(y1[2], y1[3]); w2.x = pkbf(y2[0], y2[1]); w2.y = pkbf(y2[2], y2[3]);
                    *(u32x2*)p = w1; *(u32x2*)(p + 32) = w2; } }
    }
};
__device__ __forceinline__ float logsig(float x) { const float e = __builtin_amdgcn_exp2f(-fabsf(x) * 1.4426950408889634f); return fminf(x, 0.f) - __builtin_amdgcn_logf(1.0f + e) * 0.6931471805599453f; }
struct EpiKVQ {
    static constexpr bool PERM = true, AFTER_DRAIN = false;
    bf16_t* QKV; size_t stride; float* LOGF; const float* bf; const float* ssq; float qscale;
    __device__ __forceinline__ void operator()(const f32x4 (&acc)[2][2][4][2], const Unit& u, int wr, int wc, int fr, int fq) const {
        const int row0 = u.pm * BM + wr * 64 + fr; float rs[2][4]; rstd_rows(ssq, row0, fq, rs);
        const int pn = u.pn;
        if (pn == 12) {
            if (wc == 0 && fq < 2) {
                const f32x4 b0 = *(const f32x4*)(bf + 8 * fq), b1 = *(const f32x4*)(bf + 8 * fq + 4);
#pragma unroll
                for (int ai = 0; ai < 2; ++ai)
#pragma unroll
                    for (int m = 0; m < 4; ++m) { const int row = row0 + ai * HALF + m * 16; const float r = rs[ai][m];
                        const f32x4 x0 = acc[ai][0][m][0] * r + b0, x1 = acc[ai][0][m][1] * r + b1;
                        const f32x4 o0 = {logsig(x0[0]), logsig(x0[1]), logsig(x0[2]), logsig(x0[3])}, o1 = {logsig(x1[0]), logsig(x1[1]), logsig(x1[2]), logsig(x1[3])};
                        *(f32x4*)(LOGF + (size_t)row * 16 + 8 * fq) = o0; *(f32x4*)(LOGF + (size_t)row * 16 + 8 * fq + 4) = o1; }
            }
            return;
        }
        bf16_t* dst = QKV + (size_t)(pn >> 2) * stride; const float sc = pn < 4 ? qscale : 1.f;
        const int col0 = (pn & 3) * BM + wc * 32 + 8 * fq;
#pragma unroll
        for (int ai = 0; ai < 2; ++ai)
#pragma unroll
            for (int m = 0; m < 4; ++m) { const int row = row0 + ai * HALF + m * 16; const float r = rs[ai][m] * sc;
#pragma unroll
                for (int bj = 0; bj < 2; ++bj) { const f32x4 v0 = acc[ai][bj][m][0] * r, v1 = acc[ai][bj][m][1] * r;
                    u32x4 w; w.x = pkbf(v0[0], v0[1]); w.y = pkbf(v0[2], v0[3]); w.z = pkbf(v1[0], v1[1]); w.w = pkbf(v1[2], v1[3]);
                    *(u32x4*)(dst + (size_t)row * DMODEL + col0 + bj * HALF) = w; } }
    }
};
struct EpiSwiglu {
    static constexpr bool PERM = true, AFTER_DRAIN = false;
    bf16_t* ACT; const float* ssq; const float* rsd; int nN;
    __device__ __forceinline__ void operator()(const f32x4 (&acc)[2][2][4][2], const Unit& u, int wr, int wc, int fr, int fq) const {
        const int row0 = u.pm * BM + wr * 64 + fr; float rs[2][4];
        if (ssq) rstd_rows(ssq, row0, fq, rs);
        else {
#pragma unroll
            for (int ai = 0; ai < 2; ++ai)
#pragma unroll
                for (int m = 0; m < 4; ++m) rs[ai][m] = rsd[row0 + ai * HALF + m * 16];
        }
        const int pnl = u.pn % nN, col0 = pnl * 128 + wc * 16 + 4 * fq;
#pragma unroll
        for (int ai = 0; ai < 2; ++ai)
#pragma unroll
            for (int m = 0; m < 4; ++m) { const int row = row0 + ai * HALF + m * 16; const float r = rs[ai][m];
#pragma unroll
                for (int bj = 0; bj < 2; ++bj) { const f32x4 gg = acc[ai][bj][m][0] * r, uu = acc[ai][bj][m][1] * r; f32x4 a;
#pragma unroll
                    for (int i = 0; i < 4; ++i) a[i] = gg[i] * __builtin_amdgcn_rcpf(1.0f + __builtin_amdgcn_exp2f(gg[i] * -1.4426950408889634f)) * uu[i];
                    u32x2 w; w.x = pkbf(a[0], a[1]); w.y = pkbf(a[2], a[3]);
                    *(u32x2*)(ACT + (size_t)row * 2816 + col0 + bj * 64) = w; } }
    }
};
struct EpiMoeDown {
    static constexpr bool PERM = true, AFTER_DRAIN = false;
    bf16_t* Y; const float* gate;
    __device__ __forceinline__ void operator()(const f32x4 (&acc)[2][2][4][2], const Unit& u, int wr, int wc, int fr, int fq) const {
        const int row0 = u.pm * BM + wr * 64 + fr, col0 = (u.pn & 3) * BM + wc * 32 + 8 * fq;
#pragma unroll
        for (int ai = 0; ai < 2; ++ai)
#pragma unroll
            for (int m = 0; m < 4; ++m) { const int row = row0 + ai * HALF + m * 16; const float r = gate[row];
#pragma unroll
                for (int bj = 0; bj < 2; ++bj) { const f32x4 v0 = acc[ai][bj][m][0] * r, v1 = acc[ai][bj][m][1] * r;
                    u32x4 w; w.x = pkbf(v0[0], v0[1]); w.y = pkbf(v0[2], v0[3]); w.z = pkbf(v1[0], v1[1]); w.w = pkbf(v1[2], v1[3]);
                    *(u32x4*)(Y + (size_t)row * DMODEL + col0 + bj * HALF) = w; } }
    }
};
struct GroupedOrder {
    int nN, T, nwg, G, c; int tb[9];
    __device__ __forceinline__ void init(const unsigned* cnt, int nN_, int G_, int c_) {
        nN = nN_; G = G_; c = c_; tb[0] = 0;
#pragma unroll
        for (int e = 0; e < 8; ++e) tb[e + 1] = tb[e] + (int)((__builtin_amdgcn_readfirstlane(cnt[e]) + 255u) >> 8);
        T = tb[8]; nwg = T * nN;
    }
    __device__ __forceinline__ bool next(int i, Unit& u) const {
        const long L = (long)i * G + c; if (L >= nwg) return false;
        int wgid = (int)L; { const int q = nwg / NXCD, r = nwg % NXCD, xcd = wgid % NXCD, off = wgid / NXCD; wgid = (xcd < r ? xcd * (q + 1) : r * (q + 1) + (xcd - r) * q) + off; }
        const int nig = WGM * nN, gid = wgid / nig, fm = gid * WGM, gsz = (T - fm) < WGM ? (T - fm) : WGM;
        const int pm = fm + ((wgid % nig) % gsz), pnl = (wgid % nig) / gsz; int e = 0;
#pragma unroll
        for (int k = 1; k < 8; ++k) e += (pm >= tb[k]) ? 1 : 0;
        u.pm = pm; u.pn = e * nN + pnl; return true;
    }
    __device__ __forceinline__ void a_ready(const Unit&) const {}
    __device__ __forceinline__ void done(const Unit&) const {}
};
template <class Epi, class Sched, bool ALIGN_EPI = false, bool SP2 = false>
__device__ __forceinline__ void gemm_phase(PG8_LAS unsigned char* lds, const Gemm g, const Sched& S, const Epi& E) {
    const int tid = threadIdx.x, wid = __builtin_amdgcn_readfirstlane(tid >> 6), lane = tid & 63, wr = wid >> 2, wc = wid & 3, fr = lane & 15, fq = lane >> 4;
    const int K = g.K, nt = K / BK;
    unsigned voffA[2], voffB[2];
#pragma unroll
    for (int i = 0; i < 2; ++i) { int R, C; stage_rc(tid * 16 + i * 8192, R, C); const int Rb = Epi::PERM ? ((R & ~31) + perm32(R & 31)) : R;
        voffA[i] = (unsigned)(R * K + C) * 2u; voffB[i] = (unsigned)(Rb * K + C) * 2u; }
    const size_t kstep = (size_t)(BK * 2);
    const size_t hstep = (size_t)HALF * K * 2;
    const size_t tstep = 2 * hstep;
    const unsigned ldsw = (unsigned)wid * 1024u;
    const int aoff = lds_byte(wr * 64 + fr, fq * 8), boff = lds_byte(wc * 32 + fr, fq * 8);
#define PG8_SA(b, h) (((b) * 2 + (h)) * HTB)
#define PG8_SB(b, h) ((4 + (b) * 2 + (h)) * HTB)
#define PG8_STAGE(bufoff, gbase, voff) do { _Pragma("unroll") for (int _i = 0; _i < 2; ++_i) \
        __builtin_amdgcn_global_load_lds((const unsigned*)((const char*)(gbase) + (voff)[_i]), (PG8_LAS unsigned*)(lds + (bufoff) + ldsw + _i * 8192), 16, 0, 0); } while (0)
#define PG8_LDA(dst, b, h) do { _Pragma("unroll") for (int m = 0; m < 4; ++m) _Pragma("unroll") for (int k = 0; k < 2; ++k) dst[m][k] = *(const PG8_LAS bf16x8*)(lds + PG8_SA(b, h) + aoff + m * 2048 + k * 1024); } while (0)
#define PG8_LDB(dst, b, h) do { _Pragma("unroll") for (int n = 0; n < 2; ++n) _Pragma("unroll") for (int k = 0; k < 2; ++k) dst[n][k] = *(const PG8_LAS bf16x8*)(lds + PG8_SB(b, h) + boff + n * 2048 + k * 1024); } while (0)
#define PG8_MMA(ai, bj, At, Bt) do { __builtin_amdgcn_s_setprio(1); _Pragma("unroll") for (int m = 0; m < 4; ++m) _Pragma("unroll") for (int n = 0; n < 2; ++n) _Pragma("unroll") for (int k = 0; k < 2; ++k) \
        acc[ai][bj][m][n] = __builtin_amdgcn_mfma_f32_16x16x32_bf16(Bt[n][k], At[m][k], acc[ai][bj][m][n], 0, 0, 0); __builtin_amdgcn_s_setprio(0); } while (0)
#define PG8_WAIT_V(n) asm volatile("s_waitcnt vmcnt(" #n ")" ::: "memory")
#define PG8_WAIT_L(n) asm volatile("s_waitcnt lgkmcnt(" #n ")" ::: "memory")
#define PG8_BAR __builtin_amdgcn_s_barrier()
#define PG8_SCHED __builtin_amdgcn_sched_barrier(0)
    Unit cur, nxt; int ui = 0;
    if (!S.next(0, cur)) return;
    f32x4 acc[2][2][4][2];
#pragma unroll
    for (int a = 0; a < 2; ++a)
#pragma unroll
        for (int b = 0; b < 2; ++b)
#pragma unroll
            for (int m = 0; m < 4; ++m)
#pragma unroll
                for (int n = 0; n < 2; ++n) acc[a][b][m][n] = (f32x4){0.f, 0.f, 0.f, 0.f};
    bf16x8 At[4][2], B0[2][2], B1[2][2];
    const char* cA = (const char*)g.A + (size_t)cur.pm * tstep; const char* cB = (const char*)g.Bt + (size_t)cur.pn * tstep;
    S.a_ready(cur);
    if constexpr (SP2) {
        PG8_STAGE(PG8_SB(0, 0), cB, voffB); PG8_STAGE(PG8_SB(0, 1), cB + hstep, voffB); PG8_STAGE(PG8_SA(0, 0), cA, voffA); PG8_STAGE(PG8_SA(0, 1), cA + hstep, voffA);
        if (wr == 1) PG8_BAR;
        PG8_WAIT_V(2); PG8_BAR;
        PG8_STAGE(PG8_SB(1, 0), cB + kstep, voffB); PG8_STAGE(PG8_SA(1, 0), cA + kstep, voffA); PG8_STAGE(PG8_SB(1, 1), cB + hstep + kstep, voffB);
        PG8_WAIT_V(6); PG8_BAR;
    } else {
        PG8_STAGE(PG8_SB(0, 0), cB, voffB); PG8_STAGE(PG8_SA(0, 0), cA, voffA); PG8_STAGE(PG8_SB(0, 1), cB + hstep, voffB); PG8_STAGE(PG8_SA(0, 1), cA + hstep, voffA);
        if (wr == 1) PG8_BAR;
        PG8_WAIT_V(4); PG8_BAR;
        PG8_STAGE(PG8_SB(1, 0), cB + kstep, voffB); PG8_STAGE(PG8_SA(1, 0), cA + kstep, voffA); PG8_STAGE(PG8_SB(1, 1), cB + hstep + kstep, voffB);
        PG8_WAIT_V(6); PG8_BAR;
    }
    for (;;) {
        const bool has_next = S.next(ui + 1, nxt);
        const char* nA = has_next ? (const char*)g.A + (size_t)nxt.pm * tstep : cA; const char* nB = has_next ? (const char*)g.Bt + (size_t)nxt.pn * tstep : cB;
        for (int t = 0; t < nt; t += 2) {
            const bool last = (t == nt - 2);
            const char* a1 = cA + (size_t)(t + 1) * kstep;
            const char* a2 = last ? nA : cA + (size_t)(t + 2) * kstep; const char* b2 = last ? nB : cB + (size_t)(t + 2) * kstep;
            const char* a3 = a2 + kstep; const char* b3 = b2 + kstep;
            if (last && has_next) S.a_ready(nxt);
            if constexpr (SP2) {
            PG8_LDB(B0, 0, 0); PG8_LDB(B1, 0, 1); PG8_SCHED; PG8_LDA(At, 0, 0); PG8_STAGE(PG8_SA(1, 1), a1 + hstep, voffA);
            PG8_WAIT_V(8); PG8_WAIT_L(0); PG8_BAR; PG8_MMA(0, 0, At, B0); PG8_MMA(0, 1, At, B1); PG8_BAR; PG8_SCHED;
            PG8_LDA(At, 0, 1); PG8_STAGE(PG8_SB(0, 0), b2, voffB); PG8_STAGE(PG8_SB(0, 1), b2 + hstep, voffB); PG8_STAGE(PG8_SA(0, 0), a2, voffA);
            PG8_WAIT_V(8); PG8_WAIT_L(0); PG8_BAR; PG8_MMA(1, 0, At, B0); PG8_MMA(1, 1, At, B1); PG8_BAR; PG8_SCHED;
            PG8_LDB(B0, 1, 0); PG8_LDB(B1, 1, 1); PG8_SCHED; PG8_LDA(At, 1, 0); PG8_STAGE(PG8_SA(0, 1), a2 + hstep, voffA);
            PG8_WAIT_V(8); PG8_WAIT_L(0); PG8_BAR; PG8_MMA(0, 0, At, B0); PG8_MMA(0, 1, At, B1); PG8_BAR; PG8_SCHED;
            PG8_LDA(At, 1, 1); PG8_STAGE(PG8_SB(1, 0), b3, voffB); PG8_STAGE(PG8_SB(1, 1), b3 + hstep, voffB); PG8_STAGE(PG8_SA(1, 0), a3, voffA);
            PG8_WAIT_V(8); PG8_WAIT_L(0); PG8_BAR; PG8_MMA(1, 0, At, B0); PG8_MMA(1, 1, At, B1); PG8_BAR; PG8_SCHED;
            } else {
            PG8_LDB(B0, 0, 0); PG8_SCHED; PG8_LDA(At, 0, 0); PG8_STAGE(PG8_SA(1, 1), a1 + hstep, voffA);
            PG8_WAIT_L(8); PG8_BAR; PG8_WAIT_L(0); PG8_MMA(0, 0, At, B0); PG8_BAR; PG8_SCHED;
            PG8_LDB(B1, 0, 1); PG8_STAGE(PG8_SB(0, 0), b2, voffB);
            PG8_BAR; PG8_WAIT_L(0); PG8_MMA(0, 1, At, B1); PG8_BAR;
            PG8_LDA(At, 0, 1); PG8_STAGE(PG8_SA(0, 0), a2, voffA);
            PG8_BAR; PG8_WAIT_L(0); PG8_MMA(1, 0, At, B0); PG8_BAR; PG8_SCHED;
            PG8_STAGE(PG8_SB(0, 1), b2 + hstep, voffB);
            PG8_WAIT_V(6); PG8_BAR; PG8_MMA(1, 1, At, B1); PG8_BAR;
            PG8_LDB(B0, 1, 0); PG8_SCHED; PG8_LDA(At, 1, 0); PG8_STAGE(PG8_SA(0, 1), a2 + hstep, voffA);
            PG8_WAIT_L(8); PG8_BAR; PG8_WAIT_L(0); PG8_MMA(0, 0, At, B0); PG8_BAR; PG8_SCHED;
            PG8_LDB(B1, 1, 1); PG8_STAGE(PG8_SB(1, 0), b3, voffB);
            PG8_BAR; PG8_WAIT_L(0); PG8_MMA(0, 1, At, B1); PG8_BAR;
            PG8_LDA(At, 1, 1); PG8_STAGE(PG8_SA(1, 0), a3, voffA);
            PG8_BAR; PG8_WAIT_L(0); PG8_MMA(1, 0, At, B0); PG8_BAR; PG8_SCHED;
            PG8_STAGE(PG8_SB(1, 1), b3 + hstep, voffB);
            PG8_WAIT_V(6); PG8_BAR; PG8_MMA(1, 1, At, B1); PG8_BAR;
            }
        }
        if constexpr (ALIGN_EPI) { if (wr == 0) PG8_BAR; }
        if constexpr (!Epi::AFTER_DRAIN) { E(acc, cur, wr, wc, fr, fq); S.done(cur); }
        if (!has_next) break;
#pragma unroll
        for (int a = 0; a < 2; ++a)
#pragma unroll
            for (int b = 0; b < 2; ++b)
#pragma unroll
                for (int m = 0; m < 4; ++m)
#pragma unroll
                    for (int n = 0; n < 2; ++n) acc[a][b][m][n] = (f32x4){0.f, 0.f, 0.f, 0.f};
        cur = nxt; cA = nA; cB = nB; ++ui;
        if constexpr (ALIGN_EPI) { if (wr == 1) PG8_BAR; }
    }
    PG8_WAIT_V(0);
    if constexpr (!ALIGN_EPI) { if (wr == 0) PG8_BAR; }
    PG8_BAR;
    if constexpr (Epi::AFTER_DRAIN) { E.fused(acc, cur, wr, wc, fr, fq, lds, wid, lane); S.done(cur); }
#undef PG8_SA
#undef PG8_SB
#undef PG8_STAGE
#undef PG8_LDA
#undef PG8_LDB
#undef PG8_MMA
#undef PG8_WAIT_V
#undef PG8_WAIT_L
#undef PG8_BAR
#undef PG8_SCHED
}
}
#include <hip/hip_bf16.h>
#include <cmath>
namespace attn_body {
using bf16=__hip_bfloat16;
using bf16x8=__attribute__((ext_vector_type(8)))short;
using s16x4=__attribute__((ext_vector_type(4)))short;
using f32x16=__attribute__((ext_vector_type(16)))float;
using u32x4=__attribute__((ext_vector_type(4)))unsigned;
using f32x4v=__attribute__((ext_vector_type(4)))float;
constexpr int BATCH=2,NHEAD=16,SEQ=8192,D=64,DM=NHEAD*D;
constexpr int NW=8,QBLK=32,QB=QBLK*NW,KVBLK=64,NQB=SEQ/QB;
constexpr int ATTN_PITCH=DM, ATTN_UNIT_ROWS=QB;
__device__ __forceinline__ int crow(int r,int hi){return (r&3)+8*(r>>2)+4*hi;}
#define SBAR() __builtin_amdgcn_sched_barrier(0)
__device__ __forceinline__ void cmask(f32x16&p0,f32x16&p1,int jb,int qrel,int hi){
  const float NEG=-INFINITY; int d=qrel-(64*jb+4*hi); asm volatile("":"+v"(d));
  #pragma unroll
  for(int r=0;r<16;++r){const int c=(r&3)+8*(r>>2); if(c>d)p0[r]=NEG; if(c+32>d)p1[r]=NEG;}
}

constexpr int NSLOT=3, SLOTB=8192;
constexpr int LDS_K=0, LDS_V=NSLOT*SLOTB, LDS_WS=2*NSLOT*SLOTB, LDS_OST=LDS_WS+NW*64*4, LDS_ATT=LDS_OST+NW*4096, LDS_GK=LDS_ATT, LDS_BYTES=LDS_ATT+(SEQ+QB)*4;
constexpr float C2=0.125f*1.4426950408889634f;
__device__ __forceinline__ void glds16(const void*gsrc,unsigned lds_dst){unsigned keep;
  asm volatile("s_mov_b32 %0, m0\n\ts_mov_b32 m0, %2\n\ts_nop 0\n\tglobal_load_lds_dwordx4 %1, off\n\ts_mov_b32 m0, %0":"=&s"(keep):"v"(gsrc),"s"(lds_dst):"memory");}
__device__ __forceinline__ void glds4(const void*gsrc,unsigned lds_dst){unsigned keep;
  asm volatile("s_mov_b32 %0, m0\n\ts_mov_b32 m0, %2\n\ts_nop 0\n\tglobal_load_lds_dword %1, off\n\ts_mov_b32 m0, %0":"=&s"(keep):"v"(gsrc),"s"(lds_dst):"memory");}
__device__ __forceinline__ float max3f(float a,float b,float c){float r;asm("v_max3_f32 %0, %1, %2, %3":"=v"(r):"v"(a),"v"(b),"v"(c));return r;}
__device__ __forceinline__ float max2f(float a,float b){float r;asm("v_max_f32_e32 %0, %1, %2":"=v"(r):"v"(a),"v"(b));return r;}
__device__ __forceinline__ float fadd_s(float a,float b){float r;asm("v_add_f32_e32 %0, %1, %2":"=v"(r):"v"(a),"v"(b));return r;}
__device__ __forceinline__ float fsub_s(float a,float b){float r;asm("v_sub_f32_e32 %0, %1, %2":"=v"(r):"v"(a),"v"(b));return r;}
typedef float f32x2_t __attribute__((ext_vector_type(2))); typedef __bf16 bf16x2_t __attribute__((ext_vector_type(2)));
__device__ __forceinline__ unsigned cvtpk_s(float lo,float hi){f32x2_t v={lo,hi};bf16x2_t b=__builtin_convertvector(v,bf16x2_t);return __builtin_bit_cast(unsigned,b);}
#define WAIT_BAR(N) asm volatile("s_waitcnt vmcnt(" #N ") lgkmcnt(0)\n\ts_barrier":::"memory")

template<bool ACC> __device__ __forceinline__ void qkt(f32x16&p0,f32x16&p1,const char*Kslot,const bf16x8*qr,const f32x16&negm,int r32,int hi){
  const char*kb=Kslot+hi*1024+r32*16;
  #pragma unroll
  for(int d0=0;d0<4;++d0){
    const bf16x8 b0=*reinterpret_cast<const bf16x8*>(kb+d0*2048);
    const bf16x8 b1=*reinterpret_cast<const bf16x8*>(kb+d0*2048+512);
    if(d0==0&&!ACC){p0=__builtin_amdgcn_mfma_f32_32x32x16_bf16(b0,qr[0],negm,0,0,0);p1=__builtin_amdgcn_mfma_f32_32x32x16_bf16(b1,qr[0],negm,0,0,0);}
    else{p0=__builtin_amdgcn_mfma_f32_32x32x16_bf16(b0,qr[d0],p0,0,0,0);p1=__builtin_amdgcn_mfma_f32_32x32x16_bf16(b1,qr[d0],p1,0,0,0);}}
}
typedef __attribute__((address_space(3))) const char* lds_cptr;
typedef short v4i16_t __attribute__((ext_vector_type(4)));
__device__ __forceinline__ void kload8(bf16x8*kf,lds_cptr kp){
  kf[0]=*(const __attribute__((address_space(3))) bf16x8*)(kp);      kf[1]=*(const __attribute__((address_space(3))) bf16x8*)(kp+512);
  kf[2]=*(const __attribute__((address_space(3))) bf16x8*)(kp+2048); kf[3]=*(const __attribute__((address_space(3))) bf16x8*)(kp+2560);
  kf[4]=*(const __attribute__((address_space(3))) bf16x8*)(kp+4096); kf[5]=*(const __attribute__((address_space(3))) bf16x8*)(kp+4608);
  kf[6]=*(const __attribute__((address_space(3))) bf16x8*)(kp+6144); kf[7]=*(const __attribute__((address_space(3))) bf16x8*)(kp+6656);
}
__device__ __forceinline__ void kload2(bf16x8*kf,lds_cptr kp,int j){ kf[2*j]=*(const __attribute__((address_space(3))) bf16x8*)(kp+j*2048); kf[2*j+1]=*(const __attribute__((address_space(3))) bf16x8*)(kp+j*2048+512); }
__device__ __forceinline__ s16x4 vtr(lds_cptr p){ return __builtin_bit_cast(s16x4,__builtin_amdgcn_ds_read_tr16_b64_v4i16((__attribute__((address_space(3))) v4i16_t*)p)); }
__device__ __forceinline__ float rowmax(const f32x16&p0,const f32x16&p1){
  float a=max3f(p0[0],p0[1],p1[0]),b=max3f(p0[2],p0[3],p1[1]);a=max3f(a,p1[2],p1[3]);
  #pragma unroll
  for(int r=4;r<16;r+=4){a=max3f(a,p0[r],p0[r+1]);b=max3f(b,p0[r+2],p0[r+3]);a=max3f(a,p1[r],p1[r+1]);b=max3f(b,p1[r+2],p1[r+3]);}
  const float m=max2f(a,b);
  auto rr=__builtin_amdgcn_permlane32_swap(__float_as_uint(m),__float_as_uint(m),false,false);
  return max2f(__uint_as_float(rr[0]),__uint_as_float(rr[1]));
}
__device__ __forceinline__ void pv(f32x16*o,int vb,bf16x8 pa0,bf16x8 pa1,bf16x8 pa2,bf16x8 pa3){
  #pragma unroll
  for(int d0=0;d0<2;++d0){s16x4 lo[4],hi[4];
    #pragma unroll
    for(int ks=0;ks<4;++ks){
      asm volatile("ds_read_b64_tr_b16 %0,%1 offset:%c2":"=&v"(lo[ks]):"v"(vb),"i"(d0*4096+ks*1024):"memory");
      asm volatile("ds_read_b64_tr_b16 %0,%1 offset:%c2":"=&v"(hi[ks]):"v"(vb),"i"(d0*4096+ks*1024+512):"memory");}
    asm volatile("s_waitcnt lgkmcnt(0)":::"memory");SBAR();
    #define PK(k) (bf16x8){lo[k][0],lo[k][1],lo[k][2],lo[k][3],hi[k][0],hi[k][1],hi[k][2],hi[k][3]}
    o[d0]=__builtin_amdgcn_mfma_f32_32x32x16_bf16(pa0,PK(0),o[d0],0,0,0);
    o[d0]=__builtin_amdgcn_mfma_f32_32x32x16_bf16(pa1,PK(1),o[d0],0,0,0);
    o[d0]=__builtin_amdgcn_mfma_f32_32x32x16_bf16(pa2,PK(2),o[d0],0,0,0);
    o[d0]=__builtin_amdgcn_mfma_f32_32x32x16_bf16(pa3,PK(3),o[d0],0,0,0);
    #undef PK
  }
}

#ifndef ATTN_STORE16
#define ATTN_STORE16(p,v) (*(u32x4*)(p)=(v))
#endif
template<int MODE,int THRL> __device__ __forceinline__ void attn_unit(int b,int h,int qb,const bf16*Q,const bf16*__restrict__ K,const bf16*__restrict__ V,bf16*O,char*shm,const float*GKg,const unsigned long long*MKT){
  const int tid=threadIdx.x,lane=tid&63,r32=lane&31,hi=lane>>5; const int wid=__builtin_amdgcn_readfirstlane(tid>>6);
  const long rowbase=(long)b*SEQ; const int q0=qb*QB;
  const bf16*Qw=Q+(rowbase+q0+wid*QBLK)*DM+h*D;
  const bf16*Kh=K+rowbase*DM+h*D,*Vh=V+rowbase*DM+h*D;
  const lds_cptr shm3=(lds_cptr)shm;
  const unsigned lds0=(unsigned)(uintptr_t)shm;
  float*wsf=(float*)(shm+LDS_WS)+wid*64;
  const bf16*ksrc=Kh+(long)lane*DM+wid*8;
  const bf16*vsrc=Vh+(long)(16*(wid&3)+(lane>>2))*DM+(wid>>2)*32+(lane&3)*8;
  const unsigned kdst=lds0+LDS_K+wid*1024, vdst=lds0+LDS_V+wid*1024;
  #define DMA_K(t,slot) glds16(ksrc+(long)(t)*KVBLK*DM,(unsigned)__builtin_amdgcn_readfirstlane(kdst+(slot)))
  #define DMA_V(t,slot) glds16(vsrc+(long)(t)*KVBLK*DM,(unsigned)__builtin_amdgcn_readfirstlane(vdst+(slot)))
  const int vb0=(int)(lds0+LDS_V)+((lane>>4)&1)*32+(lane&3)*8+(4*hi+((lane&15)>>2))*64;
  const char*Kbase=shm+LDS_K; bf16x8 kf[8];
  const lds_cptr kp0=shm3+LDS_K+hi*1024+r32*16; const lds_cptr vp0=shm3+LDS_V+((lane>>4)&1)*32+(lane&3)*8+(4*hi+((lane&15)>>2))*64;
  const int NT=(q0+QB)/KVBLK;
  const int qrel=wid*QBLK+r32;
  #define MLOAD(t) glds4(msrc+(size_t)(t)*(SEQ*2),(unsigned)__builtin_amdgcn_readfirstlane(mdst+(((t)&1)<<8)))
  #define APPLY(P0,P1,tt) do{ if constexpr(MODE==1){ unsigned long long w_=*(const __attribute__((address_space(3))) unsigned long long*)(shm3+LDS_GK+wid*512+(((tt)&1)<<8)+r32*8); \
      w_=((tt)<=((q0+qrel)>>6))?w_:0ull; w_>>=(4*hi); const unsigned ml_=(unsigned)w_, mh_=(unsigned)(w_>>32); \
      _Pragma("unroll") for(int r=0;r<16;++r){ const int ps_=(r&3)+8*(r>>2); \
        P0[r]=__uint_as_float(__float_as_uint(P0[r])&(unsigned)__builtin_amdgcn_sbfe((int)ml_,ps_,1)); P1[r]=__uint_as_float(__float_as_uint(P1[r])&(unsigned)__builtin_amdgcn_sbfe((int)mh_,ps_,1)); } } }while(0)
  #define LOADBIAS(X0,X1,tt) do{ if constexpr(MODE==0){ const lds_f4p g_=(lds_f4p)(shm3+LDS_GK+16*hi)+(tt)*16; \
      _Pragma("unroll") for(int g4=0;g4<4;++g4){ const f32x4v a_=g_[2*g4], b_=g_[8+2*g4]; \
        _Pragma("unroll") for(int i_=0;i_<4;++i_){ X0[4*g4+i_]=a_[i_]; X1[4*g4+i_]=b_[i_]; } } } }while(0)
  #define CINIT(X) (*(MODE==0?&(X):&negm))
  typedef __attribute__((address_space(3))) const f32x4v* lds_f4p;
  const unsigned*msrc=nullptr; unsigned mdst=0u;
  if constexpr(MODE==1){ msrc=(const unsigned*)(MKT+(size_t)b*(SEQ/KVBLK)*SEQ+(q0+wid*QBLK+(lane>>1)))+(lane&1); mdst=lds0+LDS_GK+wid*512; MLOAD(0); }
  if constexpr(MODE==0){
    const float*src=GKg+(size_t)(b*NHEAD+h)*SEQ; const float ref=src[q0]; __attribute__((address_space(3))) float*gk=(__attribute__((address_space(3))) float*)(shm3+LDS_GK);
    for(int i=tid*4;i<q0+QB;i+=NW*64*4){ f32x4v v=*(const f32x4v*)(src+i); v=v-ref; *(__attribute__((address_space(3))) f32x4v*)(gk+i)=v; }
  }
  DMA_K(0,0);DMA_V(0,0);DMA_K(1,SLOTB);
  bf16x8 qr[4];
  #pragma unroll
  for(int d0=0;d0<4;++d0)qr[d0]=*reinterpret_cast<const bf16x8*>(&Qw[(long)r32*DM+d0*16+hi*8]);
  float mhat=0.f,l_reg=0.f;f32x16 o[2];o[0]=f32x16{};o[1]=f32x16{};f32x16 negm=f32x16{};if constexpr(MODE!=0){asm volatile("":"+v"(negm));}
  #define CMASK(P0,P1,t) do{ if constexpr(MODE==0){ int jb_=(t)-(NT-4); if(jb_>=0)cmask(P0,P1,jb_,qrel,hi);} }while(0)
  bool resc=false;
  #define START(P0,P1) do{ const float rm=rowmax(P0,P1); resc=false; \
    { const float dl=rm; mhat=fadd_s(mhat,dl); \
      _Pragma("unroll") for(int r=0;r<16;++r){P0[r]=fsub_s(P0[r],dl);P1[r]=fsub_s(P1[r],dl);} \
      if constexpr(MODE!=0){ _Pragma("unroll") for(int r=0;r<16;++r)negm[r]=-mhat; asm volatile("":"+v"(negm)); } } \
    _Pragma("unroll") for(int r=0;r<16;++r)P0[r]=__builtin_amdgcn_exp2f(P0[r]); }while(0)
  #define RESC() do{ if(resc){ asm volatile("s_waitcnt lgkmcnt(0)":::"memory"); \
      _Pragma("unroll") for(int d_=0;d_<2;++d_) _Pragma("unroll") for(int r=0;r<16;++r)o[d_][r]*=wsf[crow(r,hi)]; } }while(0)
  f32x16 pA0,pA1,pB0,pB1;
  int sl_prev=0,sl_cur=0,sl_next=SLOTB;
  #define ROT() do{sl_prev=sl_cur;sl_cur=sl_next;sl_next=(sl_next==(NSLOT-1)*SLOTB)?0:sl_next+SLOTB;}while(0)
  DMA_K(2,2*SLOTB);
  WAIT_BAR(3);
  LOADBIAS(pA0,pA1,0); qkt<MODE==0>(pA0,pA1,Kbase,qr,negm,r32,hi);asm volatile("s_nop 15\n\ts_nop 7":"+v"(pA0),"+v"(pA1));CMASK(pA0,pA1,0);
  START(pA0,pA1);
  _Pragma("unroll") for(int r=0;r<16;++r)pA1[r]=__builtin_amdgcn_exp2f(pA1[r]);
  WAIT_BAR(0);
  DMA_K(3,0);DMA_V(1,SLOTB);
  ROT();
  kload8(kf,kp0+sl_cur);
  WAIT_BAR(2);
  s16x4 vlo[8],vhi[8]; u32x4 pw0,pw1,pw2,pw3;
  #define PKW(P,B) cvtpk_s(P[B],P[B+1])
  #define PAF(k) __builtin_bit_cast(bf16x8,pw##k)
  #define VFR(i) (bf16x8){vlo[i][0],vlo[i][1],vlo[i][2],vlo[i][3],vhi[i][0],vhi[i][1],vhi[i][2],vhi[i][3]}
  #define PIN(x) asm volatile("":"+v"(x))
  #define MX3(a,b,c) __builtin_fmaxf(__builtin_fmaxf((a),(b)),(c))
  #define GAPA(MF,A0,A1,A2,A3,W0,W1,PW) do{ MF; sacc+=A0; sacc+=A1; sacc+=A2; sacc+=A3; PIN(sacc); W0; W1; PIN(PW); SBAR(); }while(0)
  #define EX(v) __builtin_amdgcn_exp2f(v)
  #define GAPB(MF,X,B) do{ MF; X[B]=EX(X[B]); X[B+1]=EX(X[B+1]); X[B+2]=EX(X[B+2]); X[B+3]=EX(X[B+3]); PIN(X); SBAR(); }while(0)
  #define VRD(i) do{ vlo[i]=vtr(vp_+(((i)>>2)*4096+((i)&3)*1024)); vhi[i]=vtr(vp_+(((i)>>2)*4096+((i)&3)*1024+512)); }while(0)
  #define KRD(G,j) do{ if(G){ kload2(kf,kp0+sl_next,j); SBAR(); } }while(0)
  #define STEP(C0,C1,P0,P1,t,GK,GV,GL) do{ SBAR(); if constexpr(MODE==1){ APPLY(P0,P1,(t)-1); MLOAD(t); SBAR(); } if constexpr(MODE==0){ LOADBIAS(C0,C1,t); SBAR(); } \
    const lds_cptr vp_=vp0+sl_prev; \
    VRD(0); SBAR(); float sacc=(P0[0]+P0[1]); \
    GAPA(C0=__builtin_amdgcn_mfma_f32_32x32x16_bf16(kf[0],qr[0],CINIT(C0),0,0,0), P0[2],P0[3],P0[4],P0[5],     pw0[0]=PKW(P0,0), pw0[1]=PKW(P0,2), pw0); \
    VRD(4); SBAR(); GAPA(C1=__builtin_amdgcn_mfma_f32_32x32x16_bf16(kf[1],qr[0],CINIT(C1),0,0,0), P0[6],P0[7],P0[8],P0[9],     pw0[2]=PKW(P0,4), pw0[3]=PKW(P0,6), pw0); \
    VRD(1); SBAR(); GAPA(C0=__builtin_amdgcn_mfma_f32_32x32x16_bf16(kf[2],qr[1],C0,0,0,0),   P0[10],P0[11],P0[12],P0[13], pw1[0]=PKW(P0,8), pw1[1]=PKW(P0,10), pw1); \
    VRD(5); SBAR(); GAPA(C1=__builtin_amdgcn_mfma_f32_32x32x16_bf16(kf[3],qr[1],C1,0,0,0),   P0[14],P0[15],P1[0],P1[1],   pw1[2]=PKW(P0,12),pw1[3]=PKW(P0,14), pw1); \
    VRD(2); SBAR(); GAPA(C0=__builtin_amdgcn_mfma_f32_32x32x16_bf16(kf[4],qr[2],C0,0,0,0),   P1[2],P1[3],P1[4],P1[5],     pw2[0]=PKW(P1,0), pw2[1]=PKW(P1,2), pw2); \
    VRD(6); SBAR(); GAPA(C1=__builtin_amdgcn_mfma_f32_32x32x16_bf16(kf[5],qr[2],C1,0,0,0),   P1[6],P1[7],P1[8],P1[9],     pw2[2]=PKW(P1,4), pw2[3]=PKW(P1,6), pw2); \
    VRD(3); SBAR(); GAPA(C0=__builtin_amdgcn_mfma_f32_32x32x16_bf16(kf[6],qr[3],C0,0,0,0),   P1[10],P1[11],P1[12],P1[13], pw3[0]=PKW(P1,8), pw3[1]=PKW(P1,10), pw3); \
    VRD(7); SBAR(); GAPA(C1=__builtin_amdgcn_mfma_f32_32x32x16_bf16(kf[7],qr[3],C1,0,0,0),   P1[14],P1[15],0.f,0.f,       pw3[2]=PKW(P1,12),pw3[3]=PKW(P1,14), pw3); \
    l_reg+=sacc; \
    if(GK){DMA_K((t)+3,sl_cur);} if(GV){DMA_V((t)+1,sl_next);} \
    CMASK(C0,C1,t); \
    { float a=MX3(C0[0],C0[1],C1[0]),b=MX3(C0[2],C0[3],C1[1]); a=MX3(a,C1[2],C1[3]); \
      _Pragma("unroll") for(int r=4;r<16;r+=4){a=MX3(a,C0[r],C0[r+1]);b=MX3(b,C0[r+2],C0[r+3]);a=MX3(a,C1[r],C1[r+1]);b=MX3(b,C1[r+2],C1[r+3]);} \
      float rm=__builtin_fmaxf(a,b); { auto rr=__builtin_amdgcn_permlane32_swap(__float_as_uint(rm),__float_as_uint(rm),false,false); rm=__builtin_fmaxf(__uint_as_float(rr[0]),__uint_as_float(rr[1])); } \
      resc=false; if constexpr(MODE==0){ rm-=mhat; } \
      if(__builtin_expect(__any(rm>(float)THRL),0)){ const float dl=__builtin_fmaxf(rm,0.f); mhat+=dl; \
        if constexpr(MODE!=0){ _Pragma("unroll") for(int r=0;r<16;++r){C0[r]-=dl;C1[r]-=dl;} \
        _Pragma("unroll") for(int r=0;r<16;++r)negm[r]=-mhat; asm volatile("":"+v"(negm)); } \
        const float f=__builtin_amdgcn_exp2f(-dl); l_reg*=f; if(hi==0)wsf[r32]=f; resc=true; } \
      if constexpr(MODE==0){ _Pragma("unroll") for(int r=0;r<16;++r){C0[r]-=mhat;C1[r]-=mhat;} } } \
    SBAR(); \
    GAPB(o[0]=__builtin_amdgcn_mfma_f32_32x32x16_bf16(PAF(0),VFR(0),o[0],0,0,0), C0,0); \
    GAPB(o[1]=__builtin_amdgcn_mfma_f32_32x32x16_bf16(PAF(0),VFR(4),o[1],0,0,0), C0,4); \
    KRD(GL,0); GAPB(o[0]=__builtin_amdgcn_mfma_f32_32x32x16_bf16(PAF(1),VFR(1),o[0],0,0,0), C0,8); \
    KRD(GL,1); GAPB(o[1]=__builtin_amdgcn_mfma_f32_32x32x16_bf16(PAF(1),VFR(5),o[1],0,0,0), C0,12); \
    KRD(GL,2); GAPB(o[0]=__builtin_amdgcn_mfma_f32_32x32x16_bf16(PAF(2),VFR(2),o[0],0,0,0), C1,0); \
    KRD(GL,3); GAPB(o[1]=__builtin_amdgcn_mfma_f32_32x32x16_bf16(PAF(2),VFR(6),o[1],0,0,0), C1,4); \
    GAPB(o[0]=__builtin_amdgcn_mfma_f32_32x32x16_bf16(PAF(3),VFR(3),o[0],0,0,0), C1,8); \
    GAPB(o[1]=__builtin_amdgcn_mfma_f32_32x32x16_bf16(PAF(3),VFR(7),o[1],0,0,0), C1,12); \
    }while(0)
  int t=1;
  #undef CMASK
  #define CMASK(P0,P1,t) do{}while(0)
  for(;t+5<NT;t+=2){
    STEP(pB0,pB1,pA0,pA1,t,true,true,true);     WAIT_BAR(2); RESC(); ROT();
    STEP(pA0,pA1,pB0,pB1,t+1,true,true,true);   WAIT_BAR(2); RESC(); ROT();
  }
  #undef CMASK
  #define CMASK(P0,P1,t) do{ if constexpr(MODE==0){ int jb_=(t)-(NT-4); if(jb_>=0)cmask(P0,P1,jb_,qrel,hi);} }while(0)
  #define ENDW(tt) do{ if((tt)+3<NT){WAIT_BAR(2);} else if((tt)+2<NT){WAIT_BAR(1);} else {WAIT_BAR(0);} }while(0)
  for(;t+1<NT;t+=2){
    STEP(pB0,pB1,pA0,pA1,t,(t+3<NT),(t+1<NT),(t+1<NT));       ENDW(t);   RESC(); ROT();
    STEP(pA0,pA1,pB0,pB1,t+1,(t+4<NT),(t+2<NT),(t+2<NT));     ENDW(t+1); RESC(); ROT();
  }
  STEP(pB0,pB1,pA0,pA1,NT-1,false,false,false); RESC();
  if constexpr(MODE==1){ asm volatile("s_waitcnt vmcnt(0)":::"memory"); APPLY(pB0,pB1,NT-1); }
  { float sacc=pB0[0]+pB0[1]; _Pragma("unroll") for(int r=2;r<16;++r)sacc+=pB0[r]; _Pragma("unroll") for(int r=0;r<16;++r)sacc+=pB1[r]; l_reg+=sacc;
    pw0=(u32x4){PKW(pB0,0),PKW(pB0,2),PKW(pB0,4),PKW(pB0,6)};pw1=(u32x4){PKW(pB0,8),PKW(pB0,10),PKW(pB0,12),PKW(pB0,14)};pw2=(u32x4){PKW(pB1,0),PKW(pB1,2),PKW(pB1,4),PKW(pB1,6)};pw3=(u32x4){PKW(pB1,8),PKW(pB1,10),PKW(pB1,12),PKW(pB1,14)};
    SBAR(); pv(o,vb0+sl_cur,PAF(0),PAF(1),PAF(2),PAF(3)); }
  #undef PKW
  #undef PAF
  #undef VFR
  #undef PIN
  #undef MX3
  #undef GAPA
  #undef GAPB
  #undef EX
  #undef VRD
  #undef KRD
  #undef STEP
  #undef ENDW
  {auto rr=__builtin_amdgcn_permlane32_swap(__float_as_uint(l_reg),__float_as_uint(l_reg),false,false);l_reg=__uint_as_float(rr[0])+__uint_as_float(rr[1]);}
  if(hi==0)wsf[32+r32]=l_reg;asm volatile("s_waitcnt lgkmcnt(0)":::"memory");
  float rli[16];
  #pragma unroll
  for(int r=0;r<16;++r)rli[r]=__builtin_amdgcn_rcpf(wsf[32+crow(r,hi)]);
  bf16*Ow=O+(rowbase+q0+wid*QBLK)*DM+h*D;
  { bf16*stg=(bf16*)(shm+LDS_OST)+wid*2048;
    #pragma unroll
    for(int r=0;r<16;++r){const int orow=crow(r,hi);
      #pragma unroll
      for(int d0=0;d0<2;++d0)stg[orow*64+d0*32+r32]=__float2bfloat16(o[d0][r]*rli[r]);}
    asm volatile("s_waitcnt lgkmcnt(0)":::"memory");
    #pragma unroll
    for(int i=0;i<4;++i){const int row=i*8+(lane>>3),ch=lane&7; const u32x4 v=*(const u32x4*)(stg+row*64+ch*8); ATTN_STORE16(Ow+(long)row*DM+ch*8,v);} }
  asm volatile("s_waitcnt lgkmcnt(0)\n\ts_barrier":::"memory");
  #undef DMA_K
  #undef MLOAD
  #undef APPLY
  #undef LOADBIAS
  #undef CINIT
  #undef DMA_V
  #undef CMASK
  #undef START
  #undef RESC
  #undef ROT
}
constexpr int ATTN_LDS_BYTES=LDS_BYTES;
struct AttnTensors { const bf16* Q; const bf16* K; const bf16* V; bf16* O; const float* GK; const unsigned long long* MK; };
struct AttnUnit { int bh; int qb; };
struct StaticOrder {
  int vcu;
  __device__ __forceinline__ explicit StaticOrder(int grid,int block):vcu((block%8)*(grid/8)+block/8){}
  __device__ __forceinline__ bool next(int i,AttnUnit&u)const{ if(i>=4)return false; const int s=vcu&7; u.bh=vcu>>3; u.qb=(i==0)?s:(i==1)?15-s:(i==2)?16+s:31-s; return true; }
  __device__ __forceinline__ void a_ready(const AttnUnit&)const{}
  __device__ __forceinline__ void done(const AttnUnit&)const{}
};
template<int MODE,class Sched,int THRL=8> __device__ __forceinline__ void attn_phase(char*lds,const AttnTensors&T,const Sched&S){
  AttnUnit u;
  for(int i=0;S.next(i,u);++i){ S.a_ready(u); attn_unit<MODE,THRL>(u.bh/NHEAD,u.bh%NHEAD,u.qb,T.Q,T.K,T.V,T.O,lds,T.GK,T.MK); S.done(u); }
}
#undef SBAR
#undef WAIT_BAR
}
#define GAS __attribute__((address_space(1)))
#define LAS __attribute__((address_space(3)))
typedef unsigned short bf16;
typedef unsigned v4u __attribute__((ext_vector_type(4)));
typedef float f32x4 __attribute__((ext_vector_type(4)));
typedef short bf16x8 __attribute__((ext_vector_type(8)));
typedef GAS unsigned gu32;
typedef GAS unsigned long long gu64;
#define RLX_AGENT __ATOMIC_RELAXED, __HIP_MEMORY_SCOPE_AGENT
#define LDS_WAIT() asm volatile("s_waitcnt lgkmcnt(0)" ::: "memory")
#define VM_WAIT() asm volatile("s_waitcnt vmcnt(0)" ::: "memory")
__device__ __forceinline__ unsigned long long rt() { return __builtin_amdgcn_s_memrealtime(); }
__device__ __forceinline__ unsigned f2bf(float f) { unsigned u = __builtin_bit_cast(unsigned, f); return (u + 0x7fffu + ((u >> 16) & 1u)) >> 16; }
__device__ __forceinline__ unsigned pk2(float lo, float hi) { return f2bf(lo) | (f2bf(hi) << 16); }

#define XB_TMO      128
#define XB_XCNT(j)  (256  + 64 * (j))
#define XB_XSUB(j)  (1280 + 64 * (j))
#define XB_XGEN(j)  (2304 + 64 * (j))
#define XB_TOP      3328
#define XB_TOPGEN   3392
#define XCD_BAR_WORDS 3456
#define XB_SPIN_CAP (1u << 18)

__device__ __forceinline__ unsigned xb_ld(unsigned* p)              { return __hip_atomic_load(p, __ATOMIC_RELAXED, __HIP_MEMORY_SCOPE_AGENT); }
__device__ __forceinline__ unsigned xb_add(unsigned* p, unsigned v) { return __hip_atomic_fetch_add(p, v, __ATOMIC_RELAXED, __HIP_MEMORY_SCOPE_AGENT); }
__device__ __forceinline__ unsigned xb_xcc_id() { return (unsigned)__builtin_amdgcn_s_getreg((3 << 11) | 20) & 0xFu; }
#define XB_SPIN(cond, bar) do { unsigned _sp = 0; while (cond) { __builtin_amdgcn_s_sleep(1); \
    if ((++_sp & 255u) == 0u) { if (xb_ld(&(bar)[XB_TMO])) break; if (_sp > XB_SPIN_CAP) { atomicAdd(&(bar)[XB_TMO], 1u); break; } } } } while (0)

struct XcdBarrier {
    unsigned* bar; unsigned x;
    volatile LAS unsigned* st;
};

__device__ __forceinline__ XcdBarrier xcd_barrier_post(unsigned* bar, volatile LAS unsigned* st) {
    XcdBarrier b; b.bar = bar; b.x = xb_xcc_id(); b.st = st;
    if (threadIdx.x == 0) (void)xb_add(&bar[XB_XCNT(b.x)], 1u);
    return b;
}
__device__ __forceinline__ void xcd_barrier_complete(unsigned* bar, unsigned x, unsigned& nloc, unsigned& nx) {
    const unsigned G = gridDim.x * gridDim.y * gridDim.z;
    unsigned sum, cnt, mine, sp = 0u;
    for (;;) {
        sum = 0u; cnt = 0u; mine = 0u;
#pragma unroll
        for (unsigned j = 0; j < 16; ++j) { const unsigned c = xb_ld(&bar[XB_XCNT(j)]); sum += c; cnt += (c > 0u) ? 1u : 0u; mine = (j == x) ? c : mine; }
        if (sum == G) break;
        __builtin_amdgcn_s_sleep(1);
        if ((++sp & 255u) == 0u) { if (xb_ld(&bar[XB_TMO])) break; if (sp > XB_SPIN_CAP) { atomicAdd(&bar[XB_TMO], 1u); break; } }
    }
    nloc = mine > 0u ? mine : 1u; nx = cnt > 0u ? cnt : 1u;
}

__device__ __forceinline__ void xcd_barrier(const XcdBarrier& b) {
    asm volatile("s_waitcnt vmcnt(0)" ::: "memory");
    __syncthreads();
    if (threadIdx.x == 0) {
        unsigned* bar = b.bar;
        __builtin_amdgcn_s_waitcnt(0);
        unsigned nloc = b.st[0], nx = b.st[1];
        if (nloc == 0u) { xcd_barrier_complete(bar, b.x, nloc, nx); b.st[0] = nloc; b.st[1] = nx; }
        const unsigned old = xb_add(&bar[XB_XSUB(b.x)], 1u);
        const unsigned gen = old / nloc;
        if (old + 1u == (gen + 1u) * nloc) {
            __builtin_amdgcn_fence(__ATOMIC_RELEASE, "agent");
            asm volatile("s_waitcnt vmcnt(0)" ::: "memory");
            const unsigned og = xb_add(&bar[XB_TOP], 1u);
            const unsigned tg = og / nx;
            if (og + 1u == (tg + 1u) * nx) xb_add(&bar[XB_TOPGEN], 1u);
            else XB_SPIN(xb_ld(&bar[XB_TOPGEN]) == tg, bar);
            __builtin_amdgcn_fence(__ATOMIC_ACQUIRE, "agent");
            xb_add(&bar[XB_XGEN(b.x)], 1u);
            asm volatile("s_waitcnt vmcnt(0)" ::: "memory");
        } else {
            XB_SPIN(xb_ld(&bar[XB_XGEN(b.x)]) == gen, bar);
            __builtin_amdgcn_fence(__ATOMIC_ACQUIRE, "agent");
            asm volatile("s_waitcnt vmcnt(0)" ::: "memory");
        }
    }
    __syncthreads();
}
constexpr int NWAVES = 8;
#ifndef MK_ONE_LAUNCH
#define MK_ONE_LAUNCH 0
#endif
constexpr int BATCH = 2, SEQ = 8192, D = 1024, M = BATCH * SEQ, NH = 16, HD = 64, IDXH = 8, IDXD = 64, DFF = 2816, NEXP = 8, KSEL = 256;
constexpr int AIN_N = 3 * D + IDXH * IDXD + IDXD + IDXH;
constexpr int AIN_NP = 3840;
constexpr int KVQ_NP = 3328;
constexpr int SORT_ROWS = 2 * M + NEXP * 256;
constexpr float C2 = 0.125f * 1.4426950408889634f;
constexpr float LOG2E = 1.4426950408889634f;
constexpr size_t MiB = 1u << 20;
constexpr size_t WS_CTL = 0, CTL_ZERO_BYTES = 1 * MiB;
constexpr size_t WS_COS = 1 * MiB, WS_SIN = 2 * MiB;
constexpr size_t WS_SSQ = 3 * MiB;
constexpr size_t WS_WI = 4 * MiB;
constexpr size_t WS_LOGF = 5 * MiB;
constexpr size_t WS_GK = 6 * MiB;
constexpr size_t WS_TOK = 7 * MiB;
constexpr size_t WS_RSD = 8 * MiB;
constexpr size_t WS_GATE = 9 * MiB;
constexpr size_t WS_KI = 10 * MiB;
constexpr size_t WS_W = 16 * MiB;
constexpr size_t W_AIN = WS_W, W_AIN_SZ = (size_t)AIN_NP * D * 2;
constexpr size_t W_AOUT = W_AIN + 2 * W_AIN_SZ, W_SQ_SZ = (size_t)D * D * 2;
constexpr size_t W_KVQ = W_AOUT + 2 * W_SQ_SZ, W_KVQ_SZ = (size_t)KVQ_NP * D * 2;
constexpr size_t W_BQ3 = W_KVQ + W_KVQ_SZ;
constexpr size_t W_BOUT = W_BQ3 + W_SQ_SZ;
constexpr size_t W_DGU = W_BOUT + 2 * W_SQ_SZ, W_GU_SZ = (size_t)2 * DFF * D * 2;
constexpr size_t W_DDN = W_DGU + 2 * W_GU_SZ, W_DN_SZ = (size_t)D * DFF * 2;
constexpr size_t W_MGU = W_DDN + 2 * W_DN_SZ;
constexpr size_t W_MDN = W_MGU + 16 * W_GU_SZ;
constexpr size_t W_END = W_MDN + 16 * W_DN_SZ;
static_assert(W_END <= 352 * MiB, "weights region");
constexpr size_t WS_HB = 352 * MiB;
constexpr size_t WS_Q = 384 * MiB, WS_K = 416 * MiB, WS_V = 448 * MiB;
constexpr size_t WS_QI = 480 * MiB;
constexpr size_t WS_MASK = 496 * MiB;
constexpr size_t WS_SC = 512 * MiB;
constexpr size_t WS_ACT = 768 * MiB;
constexpr size_t WS_ASORT = 960 * MiB;
constexpr size_t WS_Y = 1028 * MiB;
constexpr size_t WS_END = 1100 * MiB;
static_assert(WS_ACT + (size_t)SORT_ROWS * DFF * 2 <= WS_ASORT && WS_ASORT + (size_t)SORT_ROWS * D * 2 <= WS_Y && WS_Y + (size_t)SORT_ROWS * D * 2 <= WS_END, "ws map");
constexpr int CW_BAR = 4096;
constexpr int CW_CNT = 16384;
constexpr int RING_OFF = 0, RING_BYTES = 131072;
constexpr int LDSCTL_OFF = RING_BYTES, MISC_OFF = LDSCTL_OFF + 320;
constexpr int LDS_BYTES = 147456;

typedef unsigned short bf16;
typedef unsigned v4u __attribute__((ext_vector_type(4)));
typedef unsigned v2u __attribute__((ext_vector_type(2)));
using pg8::pkbf;

struct Frame {
    LAS unsigned char* lds;
    volatile LAS unsigned* MISC;
    gu32* ctl;
    int tid, lane, wave, vcu, G;
    unsigned char* ws;
};
__device__ __forceinline__ float wave_sum(float v) {
#pragma unroll
    for (int o = 1; o < 64; o <<= 1) v += __shfl_xor(v, o);
    return v;
}
__device__ __forceinline__ float bf2f(unsigned short b) { return __uint_as_float((unsigned)b << 16); }

__device__ __forceinline__ int map_col(int map, int n) {
    if (map == 1) { const bool plain = (n >= 2048 && n < 3072) || n >= 3648; if (plain) return n; const int d = n & 63; return (n & ~63) + 8 * ((d & 31) >> 2) + (d & 3) + 4 * (d >> 5); }
    if (map == 2) { const int j = n < DFF ? n : n - DFF; return 8 * (j >> 2) + (j & 3) + (n < DFF ? 0 : 4); }
    return n;
}
__device__ __forceinline__ void conv_item(const float* W, int K, int N, int ncols, bf16* WT, const float* gain, int map, int row_off, int col_off, LAS float* scr, int item, int lane) {
    const int nblk = (ncols + 31) / 32, kb = item / nblk, nb = item % nblk, k0 = 64 * kb, n0 = 32 * nb;
    const int nn = n0 + (lane & 31); const bool ok = nn < ncols;
#pragma unroll 8
    for (int i = 0; i < 32; ++i) { const int kk = 2 * i + (lane >> 5); float v = 0.f; if (ok) { v = W[(size_t)(k0 + kk) * N + col_off + nn]; if (gain) v *= gain[k0 + kk]; } scr[kk * 33 + (lane & 31)] = v; }
    LDS_WAIT(); asm volatile("" ::: "memory");
    const int c = lane & 7;
#pragma unroll
    for (int j = 0; j < 4; ++j) { const int n = (lane >> 3) + 8 * j; const LAS float* s = scr + (8 * c) * 33 + n;
        v4u o; o.x = pkbf(s[0 * 33], s[1 * 33]); o.y = pkbf(s[2 * 33], s[3 * 33]); o.z = pkbf(s[4 * 33], s[5 * 33]); o.w = pkbf(s[6 * 33], s[7 * 33]);
        if (n0 + n < ncols) *(GAS v4u*)(WT + (size_t)(row_off + map_col(map, n0 + n)) * K + k0 + 8 * c) = o; }
    LDS_WAIT(); asm volatile("" ::: "memory");
}
__device__ const float INVF_TAB[32] = {1.000000000e+00f, 7.498942018e-01f, 5.623413324e-01f, 4.216965139e-01f, 3.162277639e-01f, 2.371373773e-01f, 1.778279394e-01f, 1.333521456e-01f, 1.000000015e-01f, 7.498942316e-02f, 5.623413250e-02f, 4.216964915e-02f, 3.162277490e-02f, 2.371373773e-02f, 1.778279431e-02f, 1.333521400e-02f, 9.999999776e-03f, 7.498942316e-03f, 5.623413250e-03f, 4.216964822e-03f, 3.162277630e-03f, 2.371373819e-03f, 1.778279431e-03f, 1.333521446e-03f, 1.000000047e-03f, 7.498941850e-04f, 5.623413017e-04f, 4.216965172e-04f, 3.162277571e-04f, 2.371373703e-04f, 1.778279402e-04f, 1.333521504e-04f};
struct Args { const float* in[17]; float* out; unsigned char* ws; int ph_lo, ph_hi; };
typedef const volatile __attribute__((address_space(4))) Args* KArgs;
enum { I_X = 0, I_ANORM, I_AWIN, I_AWOUT, I_KVNORM, I_WKV, I_BF, I_BNORM, I_BWQ, I_BWOUT, I_FFNNORM, I_DGU, I_DDN, I_ROUTER, I_MGU, I_MDN, I_FNORM };

__device__ __forceinline__ void p0_prologue(Frame& F, const float* const (&Ain)[17]) {
    struct { const float* const* in; } A{Ain};
    LAS float* scr = (LAS float*)(F.lds + RING_OFF + F.wave * 16384);
    const int gw = F.vcu * NWAVES + F.wave, NGW = F.G * NWAVES;
    unsigned char* ws = F.ws;
    constexpr int IT_AIN = (D / 64) * ((AIN_N + 31) / 32);
    constexpr int IT_SQ = (D / 64) * (D / 32);
    constexpr int IT_KV = (D / 64) * ((2 * D + NH) / 32);
    constexpr int IT_KVF = (D / 64) * 1;
    constexpr int IT_GU = (D / 64) * (2 * DFF / 32);
    constexpr int IT_DN = (DFF / 64) * (D / 32);
    constexpr int NSMALL = 2 * IT_AIN + 2 * IT_SQ + IT_KV + IT_KVF + IT_SQ + IT_SQ + 2 * IT_SQ + 2 * IT_GU + 2 * IT_DN;
    constexpr int NITEMS = NSMALL + 16 * IT_GU + 16 * IT_DN;
    for (int it = gw; it < NITEMS; it += NGW) {
        int r = it;
        if (r >= NSMALL) {
            r -= NSMALL;
            if (r < 16 * IT_GU) { const int j = r / IT_GU; r -= j * IT_GU;
                conv_item(A.in[I_MGU] + (size_t)j * D * 2 * DFF, D, 2 * DFF, 2 * DFF, (bf16*)(ws + W_MGU + (size_t)j * W_GU_SZ), A.in[I_FFNNORM] + (2 * (j >> 3) + 1) * D, 2, 0, 0, scr, r, F.lane); continue; }
            r -= 16 * IT_GU; { const int j = r / IT_DN; r -= j * IT_DN;
                conv_item(A.in[I_MDN] + (size_t)j * DFF * D, DFF, D, D, (bf16*)(ws + W_MDN + (size_t)j * W_DN_SZ), nullptr, 0, 0, 0, scr, r, F.lane); continue; }
        }
        if (r < 2 * IT_AIN) { const int l = r / IT_AIN; r -= l * IT_AIN;
            conv_item(A.in[I_AWIN] + (size_t)l * D * AIN_N, D, AIN_N, AIN_N, (bf16*)(ws + W_AIN + l * W_AIN_SZ), A.in[I_ANORM] + l * D, 1, 0, 0, scr, r, F.lane); continue; }
        r -= 2 * IT_AIN;
        if (r < 2 * IT_SQ) { const int l = r / IT_SQ; r -= l * IT_SQ;
            conv_item(A.in[I_AWOUT] + (size_t)l * D * D, D, D, D, (bf16*)(ws + W_AOUT + l * W_SQ_SZ), nullptr, 0, 0, 0, scr, r, F.lane); continue; }
        r -= 2 * IT_SQ;
        if (r < IT_KV) { conv_item(A.in[I_WKV], D, 2 * D + NH, 2 * D, (bf16*)(ws + W_KVQ), A.in[I_KVNORM], 0, D, 0, scr, r, F.lane); continue; }
        r -= IT_KV;
        if (r < IT_KVF) { conv_item(A.in[I_WKV], D, 2 * D + NH, NH, (bf16*)(ws + W_KVQ), A.in[I_KVNORM], 0, 3 * D, 2 * D, scr, r, F.lane); continue; }
        r -= IT_KVF;
        if (r < IT_SQ) { conv_item(A.in[I_BWQ], D, D, D, (bf16*)(ws + W_KVQ), A.in[I_BNORM], 0, 0, 0, scr, r, F.lane); continue; }
        r -= IT_SQ;
        if (r < IT_SQ) { conv_item(A.in[I_BWQ] + (size_t)D * D, D, D, D, (bf16*)(ws + W_BQ3), A.in[I_BNORM] + D, 0, 0, 0, scr, r, F.lane); continue; }
        r -= IT_SQ;
        if (r < 2 * IT_SQ) { const int l = r / IT_SQ; r -= l * IT_SQ;
            conv_item(A.in[I_BWOUT] + (size_t)l * D * D, D, D, D, (bf16*)(ws + W_BOUT + l * W_SQ_SZ), nullptr, 0, 0, 0, scr, r, F.lane); continue; }
        r -= 2 * IT_SQ;
        if (r < 2 * IT_GU) { const int l = r / IT_GU; r -= l * IT_GU;
            conv_item(A.in[I_DGU] + (size_t)l * D * 2 * DFF, D, 2 * DFF, 2 * DFF, (bf16*)(ws + W_DGU + l * W_GU_SZ), A.in[I_FFNNORM] + (2 * l) * D, 2, 0, 0, scr, r, F.lane); continue; }
        r -= 2 * IT_GU;
        { const int l = r / IT_DN; r -= l * IT_DN;
            conv_item(A.in[I_DDN] + (size_t)l * DFF * D, DFF, D, D, (bf16*)(ws + W_DDN + l * W_DN_SZ), nullptr, 0, 0, 0, scr, r, F.lane); }
    }
    {
        constexpr int ZA = AIN_NP - AIN_N, ZK = KVQ_NP - (3 * D + NH), ZROWS = 2 * ZA + ZK;
        for (int zr = gw; zr < ZROWS; zr += NGW) {
            bf16* dst = zr < 2 * ZA ? (bf16*)(ws + W_AIN + (zr / ZA) * W_AIN_SZ) + (size_t)(AIN_N + zr % ZA) * D : (bf16*)(ws + W_KVQ) + (size_t)(3 * D + NH + (zr - 2 * ZA)) * D;
            ((GAS v4u*)dst)[F.lane] = (v4u){0u, 0u, 0u, 0u}; ((GAS v4u*)dst)[64 + F.lane] = (v4u){0u, 0u, 0u, 0u};
        }
    }
    {
        float* cosT = (float*)(ws + WS_COS); float* sinT = (float*)(ws + WS_SIN);
        for (int idx = (F.vcu * NWAVES + F.wave) * 64 + F.lane; idx < SEQ * 32; idx += F.G * NWAVES * 64) {
            const int t = idx >> 5, i = idx & 31;
            const float ang = (float)t * INVF_TAB[i];
            const double rev = (double)ang * 0.15915494309189535; const float fr = (float)(rev - floor(rev));
            cosT[idx] = __builtin_amdgcn_cosf(fr); sinT[idx] = __builtin_amdgcn_sinf(fr);
        }
    }
    {
        const float* x = A.in[I_X]; bf16* HB = (bf16*)(ws + WS_HB); float* ssq = (float*)(ws + WS_SSQ);
        for (int m = gw; m < M; m += NGW) {
            const GAS f32x4* xr = (const GAS f32x4*)(x + (size_t)m * D) + F.lane; float s = 0.f;
            GAS unsigned long long* o8 = (GAS unsigned long long*)(HB + (size_t)m * D) + F.lane;
#pragma unroll
            for (int j = 0; j < 4; ++j) { const f32x4 v = xr[64 * j]; s += (v.x * v.x + v.y * v.y) + (v.z * v.z + v.w * v.w);
                o8[64 * j] = (unsigned long long)pkbf(v.x, v.y) | ((unsigned long long)pkbf(v.z, v.w) << 32); }
            s = wave_sum(s);
            if (F.lane < 16) ssq[(size_t)m * 16 + F.lane] = F.lane == 0 ? s : 0.f;
        }
    }
}

typedef float f32x16 __attribute__((ext_vector_type(16)));
__device__ __forceinline__ void idx_scores_phase(Frame& F) {
    const bf16* QI = (const bf16*)(F.ws + WS_QI); const bf16* KI = (const bf16*)(F.ws + WS_KI); const float* WI = (const float*)(F.ws + WS_WI);
    _Float16* SC = (_Float16*)(F.ws + WS_SC);
    const int lane = F.lane, r32 = lane & 31, hi = lane >> 5;
    constexpr int UPB = 1088;
    for (int u = F.vcu; u < 2 * UPB; u += F.G) {
        const int b = u / UPB; int r = u % UPB; int g = 0;
        while (r >= 8 * (g + 1)) { r -= 8 * (g + 1); ++g; }
        const int j = 8 * g + r / (g + 1), kc = r % (g + 1);
        const int tok0 = b * SEQ + 64 * j + 8 * F.wave;
        bf16x8 a[2][4]; f32x4 w[2][4];
#pragma unroll
        for (int rt = 0; rt < 2; ++rt) {
#pragma unroll
            for (int ks = 0; ks < 4; ++ks) a[rt][ks] = *(const bf16x8*)(QI + (size_t)(tok0 + 4 * rt + (r32 >> 3)) * 512 + (r32 & 7) * 64 + ks * 16 + hi * 8);
#pragma unroll
            for (int tl = 0; tl < 4; ++tl) w[rt][tl] = *(const f32x4*)(WI + (size_t)(tok0 + 4 * rt + tl) * 8 + 4 * hi);
        }
        const int s_beg = 512 * kc, s_end = (512 * (kc + 1) < 64 * (j + 1)) ? 512 * (kc + 1) : 64 * (j + 1);
        const bf16* kbase = KI + (size_t)(b * SEQ + r32) * 64 + hi * 8;
        bf16x8 bk[4];
#pragma unroll
        for (int ks = 0; ks < 4; ++ks) bk[ks] = *(const bf16x8*)(kbase + (size_t)s_beg * 64 + ks * 16);
        for (int s0 = s_beg; s0 < s_end; s0 += 32) {
            bf16x8 bn[4];
            const int sn = (s0 + 32 < s_end) ? s0 + 32 : s0;
#pragma unroll
            for (int ks = 0; ks < 4; ++ks) bn[ks] = *(const bf16x8*)(kbase + (size_t)sn * 64 + ks * 16);
#pragma unroll
            for (int rt = 0; rt < 2; ++rt) {
                f32x16 d = {};
#pragma unroll
                for (int ks = 0; ks < 4; ++ks) d = __builtin_amdgcn_mfma_f32_32x32x16_bf16(a[rt][ks], bk[ks], d, 0, 0, 0);
                float tot[4];
#pragma unroll
                for (int tl = 0; tl < 4; ++tl) { float p = 0.f;
#pragma unroll
                    for (int jj = 0; jj < 4; ++jj) p += w[rt][tl][jj] * fmaxf(d[4 * tl + jj], 0.f);
                    tot[tl] = p + __shfl_xor(p, 32); }
                const float va = hi ? tot[2] : tot[0], vb = hi ? tot[3] : tot[1];
                _Float16* dst = SC + (size_t)(tok0 + 4 * rt + 2 * hi) * SEQ + s0 + r32;
                dst[0] = (_Float16)va; dst[SEQ] = (_Float16)vb;
            }
#pragma unroll
            for (int ks = 0; ks < 4; ++ks) bk[ks] = bn[ks];
        }
    }
}

__device__ __forceinline__ unsigned wave_total(unsigned cnt, int nbits) {
    unsigned tot = 0;
    for (int b = 0; b < nbits; ++b) tot += (unsigned)__builtin_popcountll(__ballot((cnt >> b) & 1u)) << b;
    return tot;
}
template <int NPK> __device__ __forceinline__ unsigned count_ge(const unsigned (&pk)[NPK], unsigned cand) {
    unsigned cnt = 0; const unsigned ch = cand << 16;
#pragma unroll
    for (int i = 0; i < NPK; ++i) { cnt += (pk[i] >= ch) ? 1u : 0u; cnt += ((pk[i] << 16) >= ch) ? 1u : 0u; }
    return wave_total(cnt, 8);
}
template <int NPK> __device__ __forceinline__ void select_row(const unsigned short* sc, int n, int lane, unsigned char* mbase  ) {
    unsigned pk[NPK];
#pragma unroll
    for (int c = 0; c < NPK / 4; ++c) {
        v4u v = (v4u){0u, 0u, 0u, 0u};
        if (512 * c + 8 * lane < n) { v = *(const GAS v4u*)(sc + 512 * c + 8 * lane);
#pragma unroll
            for (int q = 0; q < 4; ++q) { const unsigned x = v[q]; const unsigned sgn = (x >> 15) & 0x00010001u; v[q] = x ^ ((sgn * 0xFFFFu) | 0x80008000u); } }
        pk[4 * c + 0] = v.x; pk[4 * c + 1] = v.y; pk[4 * c + 2] = v.z; pk[4 * c + 3] = v.w;
    }
    unsigned T = 0;
    for (int bit = 15; bit >= 0; --bit) { const unsigned cand = T | (1u << bit); if (count_ge<NPK>(pk, cand) >= (unsigned)KSEL) T = cand; }
    const unsigned c_gt = T == 0xFFFFu ? 0u : count_ge<NPK>(pk, T + 1u);
    const unsigned c_ge = count_ge<NPK>(pk, T);
    const int need = KSEL - (int)c_gt;
    const bool all_ties = (int)(c_ge - c_gt) == need;
    int base = 0;
#pragma unroll
    for (int c = 0; c < NPK / 4; ++c) {
        if (512 * c < n) {
            unsigned gtb = 0, eqb = 0;
#pragma unroll
            for (int q = 0; q < 4; ++q) { const unsigned lo = pk[4 * c + q] & 0xFFFFu, hh = pk[4 * c + q] >> 16;
                gtb |= (lo > T ? 1u : 0u) << (2 * q); gtb |= (hh > T ? 1u : 0u) << (2 * q + 1);
                eqb |= (lo == T ? 1u : 0u) << (2 * q); eqb |= (hh == T ? 1u : 0u) << (2 * q + 1); }
            unsigned sel = gtb | eqb;
            if (!all_ties) {
                const unsigned ceq = (unsigned)__builtin_popcount(eqb); unsigned pre = 0, tot = 0;
#pragma unroll
                for (int b = 0; b < 4; ++b) { const unsigned long long bal = __ballot((ceq >> b) & 1u);
                    pre += __builtin_amdgcn_mbcnt_hi((unsigned)(bal >> 32), __builtin_amdgcn_mbcnt_lo((unsigned)bal, 0u)) << b; tot += (unsigned)__builtin_popcountll(bal) << b; }
                int k = need - base - (int)pre; unsigned take = 0;
#pragma unroll
                for (int jb = 0; jb < 8; ++jb) { const bool e = (eqb >> jb) & 1u; if (e && k > 0) { take |= 1u << jb; --k; } }
                sel = gtb | take; base += (int)tot;
            }
            if (512 * c + 8 * lane < n) mbase[(size_t)(8 * c + (lane >> 3)) * SEQ * 8 + (lane & 7)] = (unsigned char)sel;
        }
    }
}
__device__ __forceinline__ void idx_select_phase(Frame& F) {
    const unsigned short* SC = (const unsigned short*)(F.ws + WS_SC); unsigned char* MK = F.ws + WS_MASK;
    const int gw = F.vcu * NWAVES + F.wave, NGW = F.G * NWAVES, lane = F.lane;
    for (int row = gw; row < M; row += NGW) {
        const int b = row / SEQ, t = row % SEQ, n = 64 * (t / 64 + 1);
        unsigned char* mbase = MK + ((size_t)b * (SEQ / 64) * SEQ + t) * 8;
        const unsigned short* sc = SC + (size_t)row * SEQ;
        if (n <= KSEL) { if (8 * lane < n) mbase[(size_t)(lane >> 3) * SEQ * 8 + (lane & 7)] = 0xFF; }
        else if (n <= 1024) select_row<8>(sc, n, lane, mbase);
        else if (n <= 2048) select_row<16>(sc, n, lane, mbase);
        else if (n <= 4096) select_row<32>(sc, n, lane, mbase);
        else select_row<64>(sc, n, lane, mbase);
    }
}

__device__ __forceinline__ void moe_router_phase(Frame& F, const float* h, const float* wr  , const float* gain, gu32* cnt) {
    LAS float* wl = (LAS float*)(F.lds + RING_OFF);
    LAS unsigned* lcnt = (LAS unsigned*)(F.lds + RING_OFF + 32768);
    LAS unsigned* rec = (LAS unsigned*)(F.lds + RING_OFF + 32768 + 64);
    for (int i = F.tid; i < 1024 * 8; i += NWAVES * 64) wl[i] = wr[i] * gain[i >> 3];
    if (F.tid < 16) lcnt[F.tid] = 0u;
    __syncthreads();
    unsigned* TOK = (unsigned*)(F.ws + WS_TOK);
    for (int blk = F.vcu; blk < M / 64; blk += F.G) {
        for (int q = 0; q < 8; ++q) {
            const int tl = F.wave * 8 + q, t = blk * 64 + tl;
            const GAS f32x4* xr = (const GAS f32x4*)(h + (size_t)t * D) + F.lane;
            float acc[8] = {0.f, 0.f, 0.f, 0.f, 0.f, 0.f, 0.f, 0.f}; float ss = 0.f;
#pragma unroll
            for (int j = 0; j < 4; ++j) { const f32x4 v = xr[64 * j]; ss += (v.x * v.x + v.y * v.y) + (v.z * v.z + v.w * v.w);
#pragma unroll
                for (int c = 0; c < 4; ++c) { const LAS f32x4* wp = (const LAS f32x4*)(wl + (size_t)(256 * j + 4 * F.lane + c) * 8); const f32x4 w0 = wp[0], w1 = wp[1]; const float xv = v[c];
                    acc[0] += xv * w0[0]; acc[1] += xv * w0[1]; acc[2] += xv * w0[2]; acc[3] += xv * w0[3]; acc[4] += xv * w1[0]; acc[5] += xv * w1[1]; acc[6] += xv * w1[2]; acc[7] += xv * w1[3]; } }
            ss = wave_sum(ss); const float rstd = 1.0f / sqrtf(ss * (1.0f / D) + pg8::RMS_EPS_F);
            float lg[8];
#pragma unroll
            for (int e = 0; e < 8; ++e) lg[e] = wave_sum(acc[e]) * rstd;
            int e1 = 0; float l1 = lg[0];
#pragma unroll
            for (int e = 1; e < 8; ++e) if (lg[e] > l1) { l1 = lg[e]; e1 = e; }
            int e2 = -1; float l2 = -INFINITY;
#pragma unroll
            for (int e = 0; e < 8; ++e) if (e != e1 && lg[e] > l2) { l2 = lg[e]; e2 = e; }
            const float g1 = 1.0f / (1.0f + __expf(l2 - l1)), g2 = 1.0f - g1;
            if (F.lane == 0) { const unsigned s1 = atomicAdd((unsigned*)&lcnt[e1], 1u), s2 = atomicAdd((unsigned*)&lcnt[e2], 1u);
                LAS unsigned* rc = rec + tl * 8; rc[0] = (unsigned)e1; rc[1] = (unsigned)e2; rc[2] = s1; rc[3] = s2; rc[4] = __float_as_uint(g1); rc[5] = __float_as_uint(g2); rc[6] = __float_as_uint(rstd); rc[7] = 0u; }
        }
        __syncthreads();
        if (F.tid < 8) lcnt[8 + F.tid] = __hip_atomic_fetch_add(cnt + F.tid, lcnt[F.tid], __ATOMIC_RELAXED, __HIP_MEMORY_SCOPE_AGENT);
        __syncthreads();
        if (F.tid < 64) { const LAS unsigned* rc = rec + F.tid * 8; unsigned* o = TOK + (size_t)(blk * 64 + F.tid) * 8;
            const unsigned e1 = rc[0], e2 = rc[1];
            v4u a; a.x = e1; a.y = e2; a.z = rc[2] + lcnt[8 + e1]; a.w = rc[3] + lcnt[8 + e2]; v4u bq; bq.x = rc[4]; bq.y = rc[5]; bq.z = rc[6]; bq.w = 0u;
            *(v4u*)o = a; *(v4u*)(o + 4) = bq; }
        __syncthreads();
        if (F.tid < 16) lcnt[F.tid] = 0u;
        __syncthreads();
    }
}
__device__ __forceinline__ void moe_gather_phase(Frame& F, const gu32* cnt) {
    int rb[8]; { int acc = 0;
#pragma unroll
        for (int e = 0; e < 8; ++e) { rb[e] = acc * 256; acc += (int)((__builtin_amdgcn_readfirstlane(__hip_atomic_load(cnt + e, RLX_AGENT)) + 255u) >> 8); } }
    unsigned* TOK = (unsigned*)(F.ws + WS_TOK); const bf16* HB = (const bf16*)(F.ws + WS_HB); bf16* AS = (bf16*)(F.ws + WS_ASORT);
    float* RSD = (float*)(F.ws + WS_RSD); float* GATE = (float*)(F.ws + WS_GATE);
    const int gw = F.vcu * NWAVES + F.wave, NGW = F.G * NWAVES;
    for (int t = gw; t < M; t += NGW) {
        const v4u a = *(const v4u*)(TOK + (size_t)t * 8), bq = *(const v4u*)(TOK + (size_t)t * 8 + 4);
        int r1 = (int)a.z, r2 = (int)a.w;
#pragma unroll
        for (int e = 0; e < 8; ++e) { r1 += ((int)a.x == e) ? rb[e] : 0; r2 += ((int)a.y == e) ? rb[e] : 0; }
        const GAS v4u* src = (const GAS v4u*)(HB + (size_t)t * D) + F.lane; const v4u v0 = src[0], v1 = src[64];
        GAS v4u* d1 = (GAS v4u*)(AS + (size_t)r1 * D) + F.lane; GAS v4u* d2 = (GAS v4u*)(AS + (size_t)r2 * D) + F.lane;
        d1[0] = v0; d1[64] = v1; d2[0] = v0; d2[64] = v1;
        if (F.lane == 0) { RSD[r1] = __uint_as_float(bq.z); RSD[r2] = __uint_as_float(bq.z); GATE[r1] = __uint_as_float(bq.x); GATE[r2] = __uint_as_float(bq.y);
            v2u rr; rr.x = (unsigned)r1; rr.y = (unsigned)r2; *(v2u*)(TOK + (size_t)t * 8 + 2) = rr; }
    }
}
template <bool FINAL> __device__ __forceinline__ void moe_combine_phase(Frame& F, float* h, const float* fgain) {
    const unsigned* TOK = (const unsigned*)(F.ws + WS_TOK); const bf16* Y = (const bf16*)(F.ws + WS_Y); bf16* HB = (bf16*)(F.ws + WS_HB); float* ssq = (float*)(F.ws + WS_SSQ);
    const int gw = F.vcu * NWAVES + F.wave, NGW = F.G * NWAVES;
    for (int t = gw; t < M; t += NGW) {
        const v2u rr = *(const v2u*)(TOK + (size_t)t * 8 + 2);
        GAS f32x4* hr = (GAS f32x4*)(h + (size_t)t * D) + F.lane;
        const GAS v2u* y1 = (const GAS v2u*)(Y + (size_t)rr.x * D) + F.lane; const GAS v2u* y2 = (const GAS v2u*)(Y + (size_t)rr.y * D) + F.lane;
        f32x4 v[4]; float s = 0.f;
#pragma unroll
        for (int j = 0; j < 4; ++j) { v[j] = hr[64 * j]; const v2u a = y1[64 * j], bq = y2[64 * j];
            v[j].x += __uint_as_float(a.x << 16) + __uint_as_float(bq.x << 16); v[j].y += __uint_as_float(a.x & 0xFFFF0000u) + __uint_as_float(bq.x & 0xFFFF0000u);
            v[j].z += __uint_as_float(a.y << 16) + __uint_as_float(bq.y << 16); v[j].w += __uint_as_float(a.y & 0xFFFF0000u) + __uint_as_float(bq.y & 0xFFFF0000u);
            s += (v[j].x * v[j].x + v[j].y * v[j].y) + (v[j].z * v[j].z + v[j].w * v[j].w); }
        s = wave_sum(s);
        if (FINAL) { const float rstd = 1.0f / sqrtf(s * (1.0f / D) + pg8::RMS_EPS_F);
#pragma unroll
            for (int j = 0; j < 4; ++j) { const f32x4 g = ((const GAS f32x4*)fgain)[64 * j + F.lane]; hr[64 * j] = v[j] * rstd * g; } }
        else { GAS unsigned long long* o8 = (GAS unsigned long long*)(HB + (size_t)t * D) + F.lane;
#pragma unroll
            for (int j = 0; j < 4; ++j) { hr[64 * j] = v[j]; o8[64 * j] = (unsigned long long)pkbf(v[j].x, v[j].y) | ((unsigned long long)pkbf(v[j].z, v[j].w) << 32); }
            if (F.lane < 16) ssq[(size_t)t * 16 + F.lane] = F.lane == 0 ? s : 0.f; }
    }
}
__device__ __forceinline__ void fox_scan_phase(Frame& F) {
    const float* LOGF = (const float*)(F.ws + WS_LOGF); float* GK = (float*)(F.ws + WS_GK);
    LAS float* part = (LAS float*)(F.lds + RING_OFF);
    for (int bh = F.vcu; bh < BATCH * NH; bh += F.G) {
        const int b = bh / NH, hh = bh % NH; float v[16]; float run = 0.f;
#pragma unroll
        for (int k = 0; k < 16; ++k) { run += LOGF[(size_t)(b * SEQ + F.tid * 16 + k) * 16 + hh]; v[k] = run; }
        float incl = run;
#pragma unroll
        for (int o = 1; o < 64; o <<= 1) { const float up = __shfl_up(incl, o); if (F.lane >= o) incl += up; }
        if (F.lane == 63) part[F.wave] = incl;
        __syncthreads();
        float off = incl - run;
        for (int w = 0; w < F.wave; ++w) off += part[w];
#pragma unroll
        for (int k = 0; k < 16; ++k) GK[(size_t)bh * SEQ + F.tid * 16 + k] = -(off + v[k]) * LOG2E;
        __syncthreads();
    }
}

__device__ __forceinline__ Frame make_frame(unsigned char* lds_generic, KArgs ap) {
    Frame F; F.lds = (LAS unsigned char*)lds_generic; F.MISC = (volatile LAS unsigned*)(F.lds + MISC_OFF);
    int tid = threadIdx.x; asm volatile("" : "+v"(tid));
    F.tid = tid; F.lane = tid & 63; F.wave = __builtin_amdgcn_readfirstlane(tid >> 6);
    F.G = gridDim.x; { const int bx = blockIdx.x; F.vcu = (F.G % 8 == 0) ? (bx % 8) * (F.G / 8) + bx / 8 : bx; }
    F.ws = (unsigned char*)ap->ws; F.ctl = (gu32*)(F.ws + WS_CTL);
    return F;
}
__device__ __forceinline__ void phase_barrier(unsigned char* lds_generic, KArgs ap) {
    XcdBarrier bar; bar.bar = (unsigned*)((unsigned char*)ap->ws + WS_CTL) + CW_BAR; bar.x = xb_xcc_id(); bar.st = (volatile LAS unsigned*)((LAS unsigned char*)lds_generic + MISC_OFF) + 8;
    xcd_barrier(bar);
}
#define PHASE_BEGIN(k) if (ap->ph_lo <= (k) && (k) < ap->ph_hi) { Frame F = make_frame(lds_generic, ap);
#define PHASE_END(k)   if (MK_ONE_LAUNCH && (k) + 1 < ap->ph_hi) phase_barrier(lds_generic, ap); }
template <int L> __device__ __forceinline__ void layer(KArgs ap, unsigned char* lds_generic) {
    constexpr int P = (L == 0) ? 1 : (L == 1) ? 8 : (L == 2) ? 18 : 24;
#define ws (F.ws)
#define h ((float*)ap->out)
#define HB ((bf16*)(ws + WS_HB))
#define SSQ ((float*)(ws + WS_SSQ))
#define Qb ((bf16*)(ws + WS_Q))
#define Kb ((bf16*)(ws + WS_K))
#define Vb ((bf16*)(ws + WS_V))
#define cosT ((const float*)(ws + WS_COS))
#define sinT ((const float*)(ws + WS_SIN))
#define base ((L == 0) ? (const float*)ap->in[I_X] : (const float*)h)
    constexpr int PO = (L < 2) ? P + 4 : (L == 2 ? P + 3 : P + 2);
    if constexpr (L < 2) {
        PHASE_BEGIN(P) {
            pg8::Gemm g{HB, (const bf16*)(ws + W_AIN + L * W_AIN_SZ), M, AIN_NP, D}; pg8::StaticOrder S; S.init(M, AIN_NP, F.G, (int)blockIdx.x);
            pg8::EpiAin E{Qb, Kb, Vb, (bf16*)(ws + WS_QI), (bf16*)(ws + WS_KI), (float*)(ws + WS_WI), SSQ, cosT, sinT, C2};
            pg8::gemm_phase<pg8::EpiAin, pg8::StaticOrder, true, true>(F.lds + RING_OFF, g, S, E);
        } PHASE_END(P)
        PHASE_BEGIN(P + 1) idx_scores_phase(F); PHASE_END(P + 1)
        PHASE_BEGIN(P + 2) idx_select_phase(F); PHASE_END(P + 2)
        PHASE_BEGIN(P + 3) {
            const attn_body::AttnTensors AT{(const attn_body::bf16*)Qb, (const attn_body::bf16*)Kb, (const attn_body::bf16*)Vb, (attn_body::bf16*)Qb, nullptr, (const unsigned long long*)(ws + WS_MASK)};
            const attn_body::StaticOrder S((int)F.G, (int)blockIdx.x);
            attn_body::attn_phase<1, attn_body::StaticOrder>((char*)lds_generic + RING_OFF, AT, S);
        } PHASE_END(P + 3)
    } else {
        PHASE_BEGIN(P) {
            constexpr int NP = (L == 2) ? KVQ_NP : D;
            pg8::Gemm g{HB, (const bf16*)(ws + (L == 2 ? W_KVQ : W_BQ3)), M, NP, D}; pg8::StaticOrder S; S.init(M, NP, F.G, (int)blockIdx.x);
            pg8::EpiKVQ E{Qb, (size_t)(WS_K - WS_Q) / 2, (float*)(ws + WS_LOGF), (const float*)ap->in[I_BF], SSQ, C2};
            pg8::gemm_phase<pg8::EpiKVQ, pg8::StaticOrder, true, true>(F.lds + RING_OFF, g, S, E);
        } PHASE_END(P)
        if constexpr (L == 2) { PHASE_BEGIN(P + 1) fox_scan_phase(F); PHASE_END(P + 1) }
        PHASE_BEGIN(PO - 1) {
            const attn_body::AttnTensors AT{(const attn_body::bf16*)Qb, (const attn_body::bf16*)Kb, (const attn_body::bf16*)Vb, (attn_body::bf16*)Qb, (const float*)(ws + WS_GK), nullptr};
            const attn_body::StaticOrder S((int)F.G, (int)blockIdx.x);
            attn_body::attn_phase<0, attn_body::StaticOrder>((char*)lds_generic + RING_OFF, AT, S);
        } PHASE_END(PO - 1)
    }
    PHASE_BEGIN(PO) {
        const bf16* Wo = (const bf16*)(ws + (L < 2 ? W_AOUT + L * W_SQ_SZ : W_BOUT + (L - 2) * W_SQ_SZ));
        pg8::Gemm g{Qb, Wo, M, D, D}; pg8::StaticOrder S; S.init(M, D, F.G, (int)blockIdx.x);
        pg8::EpiRes E{base, h, HB, SSQ};
        pg8::gemm_phase<pg8::EpiRes, pg8::StaticOrder, true, true>(F.lds + RING_OFF, g, S, E);
    } PHASE_END(PO)
    if constexpr ((L & 1) == 0) {
        PHASE_BEGIN(PO + 1) {
            pg8::Gemm g{HB, (const bf16*)(ws + W_DGU + (L >> 1) * W_GU_SZ), M, 2 * DFF, D}; pg8::StaticOrder S; S.init(M, 2 * DFF, F.G, (int)blockIdx.x);
            pg8::EpiSwiglu E{(bf16*)(ws + WS_ACT), SSQ, nullptr, 2 * DFF / 256};
            pg8::gemm_phase<pg8::EpiSwiglu, pg8::StaticOrder, true, true>(F.lds + RING_OFF, g, S, E);
        } PHASE_END(PO + 1)
        PHASE_BEGIN(PO + 2) {
            pg8::Gemm g{(const bf16*)(ws + WS_ACT), (const bf16*)(ws + W_DDN + (L >> 1) * W_DN_SZ), M, D, DFF}; pg8::StaticOrder S; S.init(M, D, F.G, (int)blockIdx.x);
            pg8::EpiRes E{h, h, HB, SSQ};
            pg8::gemm_phase<pg8::EpiRes, pg8::StaticOrder, true, true>(F.lds + RING_OFF, g, S, E);
        } PHASE_END(PO + 2)
    } else {
#define cnt (F.ctl + CW_CNT + 64 * (L >> 1))
        PHASE_BEGIN(PO + 1) moe_router_phase(F, h, (const float*)ap->in[I_ROUTER] + (size_t)(L >> 1) * D * NEXP, (const float*)ap->in[I_FFNNORM] + L * D, cnt); PHASE_END(PO + 1)
        PHASE_BEGIN(PO + 2) moe_gather_phase(F, cnt); PHASE_END(PO + 2)
        PHASE_BEGIN(PO + 3) {
            pg8::Gemm g{(const bf16*)(ws + WS_ASORT), (const bf16*)(ws + W_MGU + (size_t)(L >> 1) * 8 * W_GU_SZ), SORT_ROWS, 2 * DFF, D};
            pg8::GroupedOrder S; S.init((const unsigned*)cnt, 2 * DFF / 256, F.G, (int)blockIdx.x);
            pg8::EpiSwiglu E{(bf16*)(ws + WS_ACT), nullptr, (const float*)(ws + WS_RSD), 2 * DFF / 256};
            pg8::gemm_phase<pg8::EpiSwiglu, pg8::GroupedOrder, true, true>(F.lds + RING_OFF, g, S, E);
        } PHASE_END(PO + 3)
        PHASE_BEGIN(PO + 4) {
            pg8::Gemm g{(const bf16*)(ws + WS_ACT), (const bf16*)(ws + W_MDN + (size_t)(L >> 1) * 8 * W_DN_SZ), SORT_ROWS, D, DFF};
            pg8::GroupedOrder S; S.init((const unsigned*)cnt, D / 256, F.G, (int)blockIdx.x);
            pg8::EpiMoeDown E{(bf16*)(ws + WS_Y), (const float*)(ws + WS_GATE)};
            pg8::gemm_phase<pg8::EpiMoeDown, pg8::GroupedOrder, true, true>(F.lds + RING_OFF, g, S, E);
        } PHASE_END(PO + 4)
        PHASE_BEGIN(PO + 5) { if constexpr (L == 3) moe_combine_phase<true>(F, h, (const float*)ap->in[I_FNORM]); else moe_combine_phase<false>(F, h, nullptr); } PHASE_END(PO + 5)
    }
#undef ws
#undef h
#undef HB
#undef SSQ
#undef Qb
#undef Kb
#undef Vb
#undef cosT
#undef sinT
#undef base
#undef cnt
}
__global__ void __launch_bounds__(NWAVES * 64, 2) yoco_fwd(Args args_unused) {
    extern __shared__ __attribute__((aligned(16))) unsigned char lds[];
    KArgs ap = (KArgs)__builtin_amdgcn_kernarg_segment_ptr();
    unsigned char* lds_generic = lds;
    {
        LAS unsigned char* l3 = (LAS unsigned char*)lds;
        for (int u = threadIdx.x; u < (LDS_BYTES - LDSCTL_OFF) / 4; u += NWAVES * 64) ((LAS unsigned*)(l3 + LDSCTL_OFF))[u] = 0u;
        __syncthreads();
        if (MK_ONE_LAUNCH) (void)xcd_barrier_post((unsigned*)((unsigned char*)ap->ws + WS_CTL) + CW_BAR, (volatile LAS unsigned*)(l3 + MISC_OFF) + 8);
    }
    PHASE_BEGIN(0) { const float* in[17];
#pragma unroll
        for (int i = 0; i < 17; ++i) in[i] = (const float*)ap->in[i];
        p0_prologue(F, in); } PHASE_END(0)
    layer<0>(ap, lds_generic);
    layer<1>(ap, lds_generic);
    layer<2>(ap, lds_generic);
    layer<3>(ap, lds_generic);
}
#undef PHASE_BEGIN
#undef PHASE_END
constexpr int N_PHASES = 1 + (4 + 1 + 2) + (4 + 1 + 5) + (3 + 1 + 2) + (2 + 1 + 5);

extern "C" void kernel_launch(void* const* d_in, const int* in_sizes, int n_in, void* d_out, int out_size, void* d_ws, size_t ws_size, hipStream_t stream) {
    static int grid = 0;
    if (grid == 0) {
        if (n_in != 17 || in_sizes[0] != M * D || out_size != M * D || ws_size < WS_END) { fprintf(stderr, "kernel_launch: unexpected shapes (n_in %d, in0 %d, out %d, ws %zu < %zu); nothing launched\n", n_in, n_in > 0 ? in_sizes[0] : -1, out_size, ws_size, (size_t)WS_END); grid = -1; return; }
        int dev = 0, cus = 0, per_cu = 0;
        if (hipGetDevice(&dev) != hipSuccess || hipDeviceGetAttribute(&cus, hipDeviceAttributeMultiprocessorCount, dev) != hipSuccess) { grid = -1; return; }
        if (hipFuncSetAttribute((const void*)yoco_fwd, hipFuncAttributeMaxDynamicSharedMemorySize, LDS_BYTES) != hipSuccess) { fprintf(stderr, "kernel_launch: hipFuncSetAttribute failed\n"); grid = -1; return; }
        if (hipOccupancyMaxActiveBlocksPerMultiprocessor(&per_cu, (const void*)yoco_fwd, NWAVES * 64, LDS_BYTES) != hipSuccess || per_cu < 1) { fprintf(stderr, "kernel_launch: occupancy query reports %d workgroups per CU\n", per_cu); }
        (void)hipGetLastError();
        grid = cus;
    }
    if (grid < 0) return;
    if (hipMemsetAsync((char*)d_ws + WS_CTL, 0, CTL_ZERO_BYTES, stream) != hipSuccess) return;
    Args a{};
    for (int i = 0; i < 17; ++i) a.in[i] = (const float*)d_in[i];
    a.out = (float*)d_out; a.ws = (unsigned char*)d_ws;
#if MK_ONE_LAUNCH
    a.ph_lo = 0; a.ph_hi = N_PHASES;
    hipLaunchKernelGGL(yoco_fwd, dim3(grid), dim3(NWAVES * 64), LDS_BYTES, stream, a);
#else
    for (int p = 0; p < N_PHASES; ++p) { a.ph_lo = p; a.ph_hi = p + 1; hipLaunchKernelGGL(yoco_fwd, dim3(grid), dim3(NWAVES * 64), LDS_BYTES, stream, a); }
#endif
}
```

```cpp
#include <hip/hip_runtime.h>
#include <cstdio>
#include <cstdint>
namespace pg8 {
#define PG8_LAS __attribute__((address_space(3)))
typedef unsigned short bf16_t;
typedef short bf16x8 __attribute__((ext_vector_type(8)));
typedef float f32x4 __attribute__((ext_vector_type(4)));
typedef unsigned u32x4 __attribute__((ext_vector_type(4)));
typedef int i32x4 __attribute__((ext_vector_type(4)));
typedef int i32x8 __attribute__((ext_vector_type(8)));
constexpr int BM = 256, BK = 64, HALF = 128, HTB = HALF * BK * 2  , STAGE_BYTES = 8 * HTB, NXCD = 8, WGM = 8;

__host__ __device__ __forceinline__ int lds_byte(int r, int c) { const int st = (r >> 4) * 2 + (c >> 5), rr = r & 15, cc = c & 31, ob = rr * 64 + cc * 2; return st * 1024 + (ob ^ (((ob >> 9) & 1) << 5)); }
__host__ __device__ __forceinline__ void stage_rc(int b, int& R, int& C) { const int st = b / 1024, sb = b % 1024, swz = sb ^ (((sb >> 9) & 1) << 5); R = (st >> 1) * 16 + swz / 64; C = (st & 1) * 32 + (swz % 64) / 2; }
__host__ __device__ __forceinline__ int perm32(int rho) { const int n = rho >> 4, i = rho & 15; return 8 * (i >> 2) + 4 * n + (i & 3); }

struct Unit { int pm, pn; };
struct Gemm { const bf16_t* A; const bf16_t* Bt; int M, N, K; };

struct StaticOrder {
    int nM, nN, nwg, G, c;
    __host__ __device__ void init(int M, int N, int G_, int c_) { nM = M / BM; nN = N / BM; nwg = nM * nN; G = G_; c = c_; }
    __host__ __device__ bool next(int i, Unit& u) const {
        const long L = (long)i * G + c; if (L >= nwg) return false;
        int wgid = (int)L; { const int q = nwg / NXCD, r = nwg % NXCD, xcd = wgid % NXCD, off = wgid / NXCD; wgid = (xcd < r ? xcd * (q + 1) : r * (q + 1) + (xcd - r) * q) + off; }
        const int nig = WGM * nN, gid = wgid / nig, fm = gid * WGM, gsz = (nM - fm) < WGM ? (nM - fm) : WGM;
        u.pm = fm + ((wgid % nig) % gsz); u.pn = (wgid % nig) / gsz; return true;
    }
    __device__ __forceinline__ void a_ready(const Unit&) const {}
    __device__ __forceinline__ void done(const Unit&) const {}
};

typedef float f32x2 __attribute__((ext_vector_type(2)));
typedef unsigned u32x2 __attribute__((ext_vector_type(2)));
__device__ __forceinline__ unsigned pkbf(float lo, float hi) { typedef __bf16 b2 __attribute__((ext_vector_type(2))); f32x2 v = {lo, hi}; b2 b = __builtin_convertvector(v, b2); return __builtin_bit_cast(unsigned, b); }
__device__ __forceinline__ unsigned pk4f8(float a, float b, float c, float d) { int w = 0; w = __builtin_amdgcn_cvt_pk_fp8_f32(a, b, w, false); w = __builtin_amdgcn_cvt_pk_fp8_f32(c, d, w, true); return (unsigned)w; }
constexpr float RMS_EPS_F = 1e-6f;
constexpr int DMODEL = 1024, SSQ_PARTS = 16;
__device__ __forceinline__ float xsum_rows(float s) {
    const auto a = __builtin_amdgcn_permlane32_swap(__float_as_uint(s), __float_as_uint(s), false, false); s = __uint_as_float(a[0]) + __uint_as_float(a[1]);
    const auto b = __builtin_amdgcn_permlane16_swap(__float_as_uint(s), __float_as_uint(s), false, false); return __uint_as_float(b[0]) + __uint_as_float(b[1]);
}
__device__ __forceinline__ void rstd_rows(const float* ssq, int row0, int fq, float (&rs)[2][4]) {
#pragma unroll
    for (int ai = 0; ai < 2; ++ai)
#pragma unroll
        for (int m = 0; m < 4; ++m) { const f32x4 p = *(const f32x4*)(ssq + (size_t)(row0 + ai * HALF + m * 16) * SSQ_PARTS + 4 * fq);
            float s = (p[0] + p[1]) + (p[2] + p[3]); s = xsum_rows(s);
            rs[ai][m] = 1.0f / sqrtf(s * (1.0f / DMODEL) + RMS_EPS_F); }
}
__device__ __forceinline__ void rstd_half(const float* ssq, int row0, int fq, float sc, float (&rs)[4]) {
#pragma unroll
    for (int m = 0; m < 4; ++m) { const f32x4 p = *(const f32x4*)(ssq + (size_t)(row0 + m * 16) * SSQ_PARTS + 4 * fq);
        float s = (p[0] + p[1]) + (p[2] + p[3]); s = xsum_rows(s); rs[m] = sc / sqrtf(s * (1.0f / DMODEL) + RMS_EPS_F); }
}
template <bool BASEF32> struct EpiRes {
    static constexpr bool PERM = true, AFTER_DRAIN = false;
    const void* base; bf16_t* out; unsigned char* hb8; float* ssq; float ascale;
    __device__ __forceinline__ void operator()(const f32x4 (&acc)[2][2][4][2], const Unit& u, int wr, int wc, int fr, int fq) const {
        const int row0 = u.pm * BM + wr * 64 + fr, col0 = u.pn * BM + wc * 32 + 8 * fq;
#pragma unroll
        for (int ai = 0; ai < 2; ++ai)
#pragma unroll
            for (int m = 0; m < 4; ++m) { const int row = row0 + ai * HALF + m * 16; float sq = 0.f;
#pragma unroll
                for (int bj = 0; bj < 2; ++bj) { const size_t off = (size_t)row * DMODEL + col0 + bj * HALF; f32x4 b0, b1;
                    if constexpr (BASEF32) { b0 = *(const f32x4*)((const float*)base + off); b1 = *(const f32x4*)((const float*)base + off + 4); }
                    else { const u32x4 w = *(const u32x4*)((const bf16_t*)base + off);
                        b0 = (f32x4){__uint_as_float(w.x << 16), __uint_as_float(w.x & 0xFFFF0000u), __uint_as_float(w.y << 16), __uint_as_float(w.y & 0xFFFF0000u)};
                        b1 = (f32x4){__uint_as_float(w.z << 16), __uint_as_float(w.z & 0xFFFF0000u), __uint_as_float(w.w << 16), __uint_as_float(w.w & 0xFFFF0000u)}; }
                    const f32x4 v0 = acc[ai][bj][m][0] * ascale + b0, v1 = acc[ai][bj][m][1] * ascale + b1;
                    { u32x4 w; w.x = pkbf(v0[0], v0[1]); w.y = pkbf(v0[2], v0[3]); w.z = pkbf(v1[0], v1[1]); w.w = pkbf(v1[2], v1[3]); *(u32x4*)(out + off) = w; }
                    if (hb8) { u32x2 w; w.x = pk4f8(v0[0], v0[1], v0[2], v0[3]); w.y = pk4f8(v1[0], v1[1], v1[2], v1[3]); *(u32x2*)(hb8 + off) = w; }
                    sq += (v0[0] * v0[0] + v0[1] * v0[1]) + (v0[2] * v0[2] + v0[3] * v0[3]) + (v1[0] * v1[0] + v1[1] * v1[1]) + (v1[2] * v1[2] + v1[3] * v1[3]); }
                sq = xsum_rows(sq);
                if (fq == 0) ssq[(size_t)row * SSQ_PARTS + u.pn * 4 + wc] = sq; }
    }
};
struct EpiAin {
    static constexpr bool PERM = true, AFTER_DRAIN = false;
    bf16_t *Q, *K, *V, *QI, *KI; float* WI; const float* ssq; const float* cosT; const float* sinT; float qscale, wscale; int pn_off;
    __device__ __forceinline__ void operator()(const f32x4 (&acc)[2][2][4][2], const Unit& u, int wr, int wc, int fr, int fq) const {
        const int row0 = u.pm * BM + wr * 64 + fr;
        const int pn = u.pn + pn_off;
        if (pn >= 8 && pn < 12) {
            const int col0 = (pn - 8) * BM + wc * 32 + 8 * fq;
#pragma unroll
            for (int ai = 0; ai < 2; ++ai) { float rs[4]; rstd_half(ssq, row0 + ai * HALF, fq, wscale, rs);
#pragma unroll
                for (int m = 0; m < 4; ++m) { const int row = row0 + ai * HALF + m * 16; const float r = rs[m];
#pragma unroll
                    for (int bj = 0; bj < 2; ++bj) { const f32x4 v0 = acc[ai][bj][m][0] * r, v1 = acc[ai][bj][m][1] * r;
                        u32x4 w; w.x = pkbf(v0[0], v0[1]); w.y = pkbf(v0[2], v0[3]); w.z = pkbf(v1[0], v1[1]); w.w = pkbf(v1[2], v1[3]);
                        *(u32x4*)(V + (size_t)row * DMODEL + col0 + bj * HALF) = w; } }
                asm volatile("" ::: "memory"); }
            return;
        }
        bf16_t* dst; int pitch, colbase; float sc = 1.f;
        if (pn < 4) { dst = Q; pitch = DMODEL; colbase = pn * BM; sc = qscale; }
        else if (pn < 8) { dst = K; pitch = DMODEL; colbase = (pn - 4) * BM; }
        else if (pn < 14) { dst = QI; pitch = 512; colbase = (pn - 12) * BM; }
        else { dst = KI; pitch = 64; colbase = 0; }
        const int g = 4 * (wc & 1) + fq;
#pragma unroll
        for (int ai = 0; ai < 2; ++ai) { float rs[4]; rstd_half(ssq, row0 + ai * HALF, fq, wscale, rs);
#pragma unroll
            for (int m = 0; m < 4; ++m) { const int row = row0 + ai * HALF + m * 16; const float r = rs[m] * sc; const int t = row & 8191;
                const f32x4 c4 = *(const f32x4*)(cosT + t * 32 + 4 * g), s4 = *(const f32x4*)(sinT + t * 32 + 4 * g);
#pragma unroll
                for (int bj = 0; bj < 2; ++bj) { const int cit = bj * HALF + wc * 32;
                    const f32x4 x1 = acc[ai][bj][m][0] * r, x2 = acc[ai][bj][m][1] * r;
                    if (pn == 14) {
                        if (cit == 64 && fq == 0) { const float ws = 0.35355339059327373f; *(f32x4*)(WI + (size_t)row * 8) = acc[ai][bj][m][0] * (rs[m] * ws); *(f32x4*)(WI + (size_t)row * 8 + 4) = acc[ai][bj][m][1] * (rs[m] * ws); }
                        if (cit >= 64) continue;
                    }
                    const f32x4 y1 = x1 * c4 - x2 * s4, y2 = x2 * c4 + x1 * s4;
                    bf16_t* p = dst + (size_t)row * pitch + colbase + (cit & ~63) + 4 * g;
                    u32x2 w1, w2; w1.x = pkbf(y1[0], y1[1]); w1.y = pkbf(y1[2], y1[3]); w2.x = pkbf(y2[0], y2[1]); w2.y = pkbf(y2[2], y2[3]);
                    *(u32x2*)p = w1; *(u32x2*)(p + 32) = w2; } }
            asm volatile("" ::: "memory"); }
    }
};
__device__ __forceinline__ float logsig(float x) { const float e = __builtin_amdgcn_exp2f(-fabsf(x) * 1.4426950408889634f); return fminf(x, 0.f) - __builtin_amdgcn_logf(1.0f + e) * 0.6931471805599453f; }
struct EpiKVQ {
    static constexpr bool PERM = true, AFTER_DRAIN = false;
    bf16_t* QKV; size_t stride; float* LOGF; const float* bf; const float* ssq; float qscale, wscale;
    __device__ __forceinline__ void operator()(const f32x4 (&acc)[2][2][4][2], const Unit& u, int wr, int wc, int fr, int fq) const {
        const int row0 = u.pm * BM + wr * 64 + fr;
        const int pn = u.pn;
        if (pn == 12) {
            if (wc == 0 && fq < 2) {
                const f32x4 b0 = *(const f32x4*)(bf + 8 * fq), b1 = *(const f32x4*)(bf + 8 * fq + 4);
#pragma unroll
                for (int ai = 0; ai < 2; ++ai) { float rs[4];
#pragma unroll
                    for (int m = 0; m < 4; ++m) { float s = 0.f;
#pragma unroll
                        for (int q = 0; q < 4; ++q) { const f32x4 p = *(const f32x4*)(ssq + (size_t)(row0 + ai * HALF + m * 16) * SSQ_PARTS + 4 * q); s += (p[0] + p[1]) + (p[2] + p[3]); }
                        rs[m] = wscale / sqrtf(s * (1.0f / DMODEL) + RMS_EPS_F); }
#pragma unroll
                    for (int m = 0; m < 4; ++m) { const int row = row0 + ai * HALF + m * 16; const float r = rs[m];
                        const f32x4 x0 = acc[ai][0][m][0] * r + b0, x1 = acc[ai][0][m][1] * r + b1;
                        const f32x4 o0 = {logsig(x0[0]), logsig(x0[1]), logsig(x0[2]), logsig(x0[3])}, o1 = {logsig(x1[0]), logsig(x1[1]), logsig(x1[2]), logsig(x1[3])};
                        *(f32x4*)(LOGF + (size_t)row * 16 + 8 * fq) = o0; *(f32x4*)(LOGF + (size_t)row * 16 + 8 * fq + 4) = o1; } }
            }
            return;
        }
        bf16_t* dst = QKV + (size_t)(pn >> 2) * stride; const float sc = pn < 4 ? qscale : 1.f;
        const int col0 = (pn & 3) * BM + wc * 32 + 8 * fq;
#pragma unroll
        for (int ai = 0; ai < 2; ++ai) { float rs[4]; rstd_half(ssq, row0 + ai * HALF, fq, wscale * sc, rs);
#pragma unroll
            for (int m = 0; m < 4; ++m) { const int row = row0 + ai * HALF + m * 16; const float r = rs[m];
#pragma unroll
                for (int bj = 0; bj < 2; ++bj) { const f32x4 v0 = acc[ai][bj][m][0] * r, v1 = acc[ai][bj][m][1] * r;
                    u32x4 w; w.x = pkbf(v0[0], v0[1]); w.y = pkbf(v0[2], v0[3]); w.z = pkbf(v1[0], v1[1]); w.w = pkbf(v1[2], v1[3]);
                    *(u32x4*)(dst + (size_t)row * DMODEL + col0 + bj * HALF) = w; } }
            asm volatile("" ::: "memory"); }
    }
};
struct EpiSwiglu {
    static constexpr bool PERM = true, AFTER_DRAIN = false;
    unsigned char* ACT; const float* ssq; const float* rsd; int nN; float wscale; int dry;
    __device__ __forceinline__ void operator()(const f32x4 (&acc)[2][2][4][2], const Unit& u, int wr, int wc, int fr, int fq) const {
        const int row0 = u.pm * BM + wr * 64 + fr;
        const int pnl = u.pn % nN, col0 = pnl * 128 + wc * 16 + 4 * fq;
#pragma unroll
        for (int ai = 0; ai < 2; ++ai) {
            float rs[4];
#pragma unroll
            for (int m = 0; m < 4; ++m) { const int row = row0 + ai * HALF + m * 16;
                if (ssq) { const f32x4 p = *(const f32x4*)(ssq + (size_t)row * SSQ_PARTS + 4 * fq); float s = (p[0] + p[1]) + (p[2] + p[3]); s = xsum_rows(s); rs[m] = wscale / sqrtf(s * (1.0f / DMODEL) + RMS_EPS_F); }
                else rs[m] = rsd[row] * wscale; }
#pragma unroll
            for (int m = 0; m < 4; ++m) { const int row = row0 + ai * HALF + m * 16; const float r = rs[m];
#pragma unroll
                for (int bj = 0; bj < 2; ++bj) { const f32x4 gg = acc[ai][bj][m][0] * r, uu = acc[ai][bj][m][1] * r; f32x4 a;
#pragma unroll
                    for (int i = 0; i < 4; ++i) a[i] = gg[i] * __builtin_amdgcn_rcpf(1.0f + __builtin_amdgcn_exp2f(gg[i] * -1.4426950408889634f)) * uu[i];
                    const unsigned pk_ = pk4f8(a[0], a[1], a[2], a[3]); if (!dry) *(unsigned*)(ACT + (size_t)row * 2816 + col0 + bj * 64) = pk_; else asm volatile("" :: "v"(pk_)); } }
            asm volatile("" ::: "memory");
        }
    }
};
struct EpiMoeDown {
    static constexpr bool PERM = true, AFTER_DRAIN = false;
    bf16_t* Y; const float* gate; float ascale;
    __device__ __forceinline__ void operator()(const f32x4 (&acc)[2][2][4][2], const Unit& u, int wr, int wc, int fr, int fq) const {
        const int row0 = u.pm * BM + wr * 64 + fr, col0 = (u.pn & 3) * BM + wc * 32 + 8 * fq;
#pragma unroll
        for (int ai = 0; ai < 2; ++ai)
#pragma unroll
            for (int m = 0; m < 4; ++m) { const int row = row0 + ai * HALF + m * 16; const float r = gate[row] * ascale;
#pragma unroll
                for (int bj = 0; bj < 2; ++bj) { const f32x4 v0 = acc[ai][bj][m][0] * r, v1 = acc[ai][bj][m][1] * r;
                    u32x4 w; w.x = pkbf(v0[0], v0[1]); w.y = pkbf(v0[2], v0[3]); w.z = pkbf(v1[0], v1[1]); w.w = pkbf(v1[2], v1[3]);
                    *(u32x4*)(Y + (size_t)row * DMODEL + col0 + bj * HALF) = w; } }
    }
};
struct GroupedOrder {
    int nu; const PG8_LAS int* tbl;
    __device__ __forceinline__ void init(const unsigned* cnt, int nN, int G, int c, PG8_LAS int* tb_lds, bool tid0) {
        int tb[9]; tb[0] = 0;
#pragma unroll
        for (int e = 0; e < 8; ++e) tb[e + 1] = tb[e] + (int)((__builtin_amdgcn_readfirstlane(cnt[e]) + 255u) >> 8);
        const int T = tb[8], nwg = T * nN; int n = 0;
        for (int i = 0; i < 32; ++i) {
            const long L = (long)i * G + c; if (L >= nwg) break;
            int wgid = (int)L; { const int q = nwg / NXCD, r = nwg % NXCD, xcd = wgid % NXCD, off = wgid / NXCD; wgid = (xcd < r ? xcd * (q + 1) : r * (q + 1) + (xcd - r) * q) + off; }
            const int nig = WGM * nN, gid = wgid / nig, fm = gid * WGM, gsz = (T - fm) < WGM ? (T - fm) : WGM;
            const int pm = fm + ((wgid % nig) % gsz), pnl = (wgid % nig) / gsz; int e = 0;
#pragma unroll
            for (int k = 1; k < 8; ++k) e += (pm >= tb[k]) ? 1 : 0;
            if (tid0) { tb_lds[2 * i] = pm; tb_lds[2 * i + 1] = e * nN + pnl; }
            n = i + 1;
        }
        nu = n; tbl = tb_lds;
        __syncthreads();
    }
    __device__ __forceinline__ bool next(int i, Unit& u) const {
        if (i >= nu) return false;
        u.pm = __builtin_amdgcn_readfirstlane(tbl[2 * i]); u.pn = __builtin_amdgcn_readfirstlane(tbl[2 * i + 1]); return true;
    }
    __device__ __forceinline__ void a_ready(const Unit&) const {}
    __device__ __forceinline__ void done(const Unit&) const {}
};
__device__ __forceinline__ int pg8_lane() { int l; asm volatile("v_mbcnt_lo_u32_b32 %0, -1, 0\n\tv_mbcnt_hi_u32_b32 %0, -1, %0" : "=v"(l)); return l; }
__device__ __forceinline__ void pg8_dma16(unsigned voff, const void* sbase, unsigned lds_dst) { unsigned keep;
    asm volatile("s_mov_b32 %0, m0\n\ts_mov_b32 m0, %3\n\ts_nop 0\n\tglobal_load_lds_dwordx4 %1, %2\n\ts_mov_b32 m0, %0" : "=&s"(keep) : "v"(voff), "s"(sbase), "s"(lds_dst) : "memory"); }
template <class Epi, class Sched, bool ALIGN_EPI = false, bool SP2 = false, int FMT = 0>
__device__ __forceinline__ void gemm_phase(PG8_LAS unsigned char* lds, const Gemm g, const Sched& S, const Epi& E, const int wv  ) {
    const int wid = wv, lane = pg8_lane(), tid = wid * 64 + lane, wr = wid >> 2, wc = wid & 3, fr = lane & 15, fq = lane >> 4;
    const int K = g.K, nt = K / BK;
    unsigned voffA[2], voffB[2];
#pragma unroll
    for (int i = 0; i < 2; ++i) { int R, C; stage_rc(tid * 16 + i * 8192, R, C); const int Rb = Epi::PERM ? ((R & ~31) + perm32(R & 31)) : R;
        voffA[i] = (unsigned)(R * K + C) * 2u; voffB[i] = (unsigned)(Rb * K + C) * 2u; }
    const size_t kstep = (size_t)(BK * 2);
    const size_t hstep = (size_t)HALF * K * 2;
    const size_t tstep = 2 * hstep;
    const unsigned lds0 = (unsigned)(unsigned long long)lds; const size_t rstep64 = (size_t)64 * K * 2;
    const unsigned ldsw = (unsigned)wid * 1024u;
    const int aoff = lds_byte(wr * 64 + fr, fq * 8), boff = lds_byte(wc * 32 + fr, fq * 8);
#define PG8_SA(b, h) (((b) * 2 + (h)) * HTB)
#define PG8_SB(b, h) ((4 + (b) * 2 + (h)) * HTB)
#define PG8_STAGE(bufoff, gbase, voff) do { _Pragma("unroll") for (int _i = 0; _i < 2; ++_i) \
        pg8_dma16((voff)[0], (const char*)(gbase) + (size_t)_i * rstep64, lds0 + (unsigned)((bufoff) + _i * 8192) + ldsw); } while (0)
#define PG8_LDA(dst, b, h) do { _Pragma("unroll") for (int m = 0; m < 4; ++m) _Pragma("unroll") for (int k = 0; k < 2; ++k) dst[m][k] = *(const PG8_LAS bf16x8*)(lds + PG8_SA(b, h) + aoff + m * 2048 + k * 1024); } while (0)
#define PG8_LDB(dst, b, h) do { _Pragma("unroll") for (int n = 0; n < 2; ++n) _Pragma("unroll") for (int k = 0; k < 2; ++k) dst[n][k] = *(const PG8_LAS bf16x8*)(lds + PG8_SB(b, h) + boff + n * 2048 + k * 1024); } while (0)
#define PG8_CAT8(x) __builtin_shufflevector(__builtin_bit_cast(i32x4, (x)[0]), __builtin_bit_cast(i32x4, (x)[1]), 0, 1, 2, 3, 4, 5, 6, 7)
#define PG8_MMA(ai, bj, At, Bt) do { if constexpr (FMT == 1) __builtin_amdgcn_sched_barrier(0); __builtin_amdgcn_s_setprio(1); \
    if constexpr (FMT == 1) { _Pragma("unroll") for (int m = 0; m < 4; ++m) _Pragma("unroll") for (int n = 0; n < 2; ++n) \
        acc[ai][bj][m][n] = __builtin_amdgcn_mfma_scale_f32_16x16x128_f8f6f4(PG8_CAT8(Bt[n]), PG8_CAT8(At[m]), acc[ai][bj][m][n], 0, 0, 0, 0x7F7F7F7F, 0, 0x7F7F7F7F); } \
    else { _Pragma("unroll") for (int m = 0; m < 4; ++m) _Pragma("unroll") for (int n = 0; n < 2; ++n) _Pragma("unroll") for (int k = 0; k < 2; ++k) \
        acc[ai][bj][m][n] = __builtin_amdgcn_mfma_f32_16x16x32_bf16(Bt[n][k], At[m][k], acc[ai][bj][m][n], 0, 0, 0); } __builtin_amdgcn_s_setprio(0); if constexpr (FMT == 1) __builtin_amdgcn_sched_barrier(0); } while (0)
#define PG8_WAIT_V(n) asm volatile("s_waitcnt vmcnt(" #n ")" ::: "memory")
#define PG8_WAIT_L(n) asm volatile("s_waitcnt lgkmcnt(" #n ")" ::: "memory")
#define PG8_BAR __builtin_amdgcn_s_barrier()
#define PG8_SCHED __builtin_amdgcn_sched_barrier(0)
    Unit cur, nxt; int ui = 0;
    if (!S.next(0, cur)) return;
    f32x4 acc[2][2][4][2];
#pragma unroll
    for (int a = 0; a < 2; ++a)
#pragma unroll
        for (int b = 0; b < 2; ++b)
#pragma unroll
            for (int m = 0; m < 4; ++m)
#pragma unroll
                for (int n = 0; n < 2; ++n) acc[a][b][m][n] = (f32x4){0.f, 0.f, 0.f, 0.f};
    bf16x8 At[4][2], B0[2][2], B1[2][2];
    const char* cA = (const char*)g.A + (size_t)cur.pm * tstep; const char* cB = (const char*)g.Bt + (size_t)cur.pn * tstep;
    S.a_ready(cur);
    if constexpr (SP2) {
        PG8_STAGE(PG8_SB(0, 0), cB, voffB); PG8_STAGE(PG8_SB(0, 1), cB + hstep, voffB); PG8_STAGE(PG8_SA(0, 0), cA, voffA); PG8_STAGE(PG8_SA(0, 1), cA + hstep, voffA);
        if (wr == 1) PG8_BAR;
        PG8_WAIT_V(2); PG8_BAR;
        PG8_STAGE(PG8_SB(1, 0), cB + kstep, voffB); PG8_STAGE(PG8_SA(1, 0), cA + kstep, voffA); PG8_STAGE(PG8_SB(1, 1), cB + hstep + kstep, voffB);
        PG8_WAIT_V(6); PG8_BAR;
    } else {
        PG8_STAGE(PG8_SB(0, 0), cB, voffB); PG8_STAGE(PG8_SA(0, 0), cA, voffA); PG8_STAGE(PG8_SB(0, 1), cB + hstep, voffB); PG8_STAGE(PG8_SA(0, 1), cA + hstep, voffA);
        if (wr == 1) PG8_BAR;
        PG8_WAIT_V(4); PG8_BAR;
        PG8_STAGE(PG8_SB(1, 0), cB + kstep, voffB); PG8_STAGE(PG8_SA(1, 0), cA + kstep, voffA); PG8_STAGE(PG8_SB(1, 1), cB + hstep + kstep, voffB);
        PG8_WAIT_V(6); PG8_BAR;
    }
    for (;;) {
        const bool has_next = S.next(ui + 1, nxt);
        const char* nA = has_next ? (const char*)g.A + (size_t)nxt.pm * tstep : cA; const char* nB = has_next ? (const char*)g.Bt + (size_t)nxt.pn * tstep : cB;
        for (int t = 0; t < nt; t += 2) {
            const bool last = (t == nt - 2);
            const char* a1 = cA + (size_t)(t + 1) * kstep;
            const char* a2 = last ? nA : cA + (size_t)(t + 2) * kstep; const char* b2 = last ? nB : cB + (size_t)(t + 2) * kstep;
            const char* a3 = a2 + kstep; const char* b3 = b2 + kstep;
            if (last && has_next) S.a_ready(nxt);
            if constexpr (SP2) {
            PG8_LDB(B0, 0, 0); PG8_LDB(B1, 0, 1); PG8_SCHED; PG8_LDA(At, 0, 0); PG8_STAGE(PG8_SA(1, 1), a1 + hstep, voffA);
            PG8_WAIT_V(8); PG8_WAIT_L(0); PG8_BAR; PG8_MMA(0, 0, At, B0); PG8_MMA(0, 1, At, B1); PG8_BAR; PG8_SCHED;
            PG8_LDA(At, 0, 1); PG8_STAGE(PG8_SB(0, 0), b2, voffB); PG8_STAGE(PG8_SB(0, 1), b2 + hstep, voffB); PG8_STAGE(PG8_SA(0, 0), a2, voffA);
            PG8_WAIT_V(8); PG8_WAIT_L(0); PG8_BAR; PG8_MMA(1, 0, At, B0); PG8_MMA(1, 1, At, B1); PG8_BAR; PG8_SCHED;
            PG8_LDB(B0, 1, 0); PG8_LDB(B1, 1, 1); PG8_SCHED; PG8_LDA(At, 1, 0); PG8_STAGE(PG8_SA(0, 1), a2 + hstep, voffA);
            PG8_WAIT_V(8); PG8_WAIT_L(0); PG8_BAR; PG8_MMA(0, 0, At, B0); PG8_MMA(0, 1, At, B1); PG8_BAR; PG8_SCHED;
            PG8_LDA(At, 1, 1); PG8_STAGE(PG8_SB(1, 0), b3, voffB); PG8_STAGE(PG8_SB(1, 1), b3 + hstep, voffB); PG8_STAGE(PG8_SA(1, 0), a3, voffA);
            PG8_WAIT_V(8); PG8_WAIT_L(0); PG8_BAR; PG8_MMA(1, 0, At, B0); PG8_MMA(1, 1, At, B1); PG8_BAR; PG8_SCHED;
            } else {
            PG8_LDB(B0, 0, 0); PG8_SCHED; PG8_LDA(At, 0, 0); PG8_STAGE(PG8_SA(1, 1), a1 + hstep, voffA);
            PG8_WAIT_L(8); PG8_BAR; PG8_WAIT_L(0); PG8_MMA(0, 0, At, B0); PG8_BAR; PG8_SCHED;
            PG8_LDB(B1, 0, 1); PG8_STAGE(PG8_SB(0, 0), b2, voffB);
            PG8_BAR; PG8_WAIT_L(0); PG8_MMA(0, 1, At, B1); PG8_BAR;
            PG8_LDA(At, 0, 1); PG8_STAGE(PG8_SA(0, 0), a2, voffA);
            PG8_BAR; PG8_WAIT_L(0); PG8_MMA(1, 0, At, B0); PG8_BAR; PG8_SCHED;
            PG8_STAGE(PG8_SB(0, 1), b2 + hstep, voffB);
            PG8_WAIT_V(6); PG8_BAR; PG8_MMA(1, 1, At, B1); PG8_BAR;
            PG8_LDB(B0, 1, 0); PG8_SCHED; PG8_LDA(At, 1, 0); PG8_STAGE(PG8_SA(0, 1), a2 + hstep, voffA);
            PG8_WAIT_L(8); PG8_BAR; PG8_WAIT_L(0); PG8_MMA(0, 0, At, B0); PG8_BAR; PG8_SCHED;
            PG8_LDB(B1, 1, 1); PG8_STAGE(PG8_SB(1, 0), b3, voffB);
            PG8_BAR; PG8_WAIT_L(0); PG8_MMA(0, 1, At, B1); PG8_BAR;
            PG8_LDA(At, 1, 1); PG8_STAGE(PG8_SA(1, 0), a3, voffA);
            PG8_BAR; PG8_WAIT_L(0); PG8_MMA(1, 0, At, B0); PG8_BAR; PG8_SCHED;
            PG8_STAGE(PG8_SB(1, 1), b3 + hstep, voffB);
            PG8_WAIT_V(6); PG8_BAR; PG8_MMA(1, 1, At, B1); PG8_BAR;
            }
        }
        if constexpr (ALIGN_EPI) { if (wr == 0) PG8_BAR; }
        if constexpr (!Epi::AFTER_DRAIN) { const int l2_ = pg8_lane(), w2_ = wv;
            E(acc, cur, w2_ >> 2, w2_ & 3, l2_ & 15, l2_ >> 4); S.done(cur); }
        if (!has_next) break;
#pragma unroll
        for (int a = 0; a < 2; ++a)
#pragma unroll
            for (int b = 0; b < 2; ++b)
#pragma unroll
                for (int m = 0; m < 4; ++m)
#pragma unroll
                    for (int n = 0; n < 2; ++n) acc[a][b][m][n] = (f32x4){0.f, 0.f, 0.f, 0.f};
        cur = nxt; cA = nA; cB = nB; ++ui;
        if constexpr (ALIGN_EPI) { if (wr == 1) PG8_BAR; }
    }
    PG8_WAIT_V(0);
    if constexpr (!ALIGN_EPI) { if (wr == 0) PG8_BAR; }
    PG8_BAR;
    if constexpr (Epi::AFTER_DRAIN) { E.fused(acc, cur, wr, wc, fr, fq, lds, wid, lane); S.done(cur); }
#undef PG8_SA
#undef PG8_SB
#undef PG8_STAGE
#undef PG8_LDA
#undef PG8_LDB
#undef PG8_MMA
#undef PG8_CAT8
#undef PG8_WAIT_V
#undef PG8_WAIT_L
#undef PG8_BAR
#undef PG8_SCHED
}
}
#include <hip/hip_bf16.h>
#include <cmath>
namespace attn_body {
using bf16=__hip_bfloat16;
using bf16x8=__attribute__((ext_vector_type(8)))short;
using s16x4=__attribute__((ext_vector_type(4)))short;
using f32x16=__attribute__((ext_vector_type(16)))float;
using u32x4=__attribute__((ext_vector_type(4)))unsigned;
using f32x4v=__attribute__((ext_vector_type(4)))float;
constexpr int BATCH=2,NHEAD=16,SEQ=8192,D=64,DM=NHEAD*D;
constexpr int NW=8,QBLK=32,QB=QBLK*NW,KVBLK=64,NQB=SEQ/QB;
constexpr int ATTN_PITCH=DM, ATTN_UNIT_ROWS=QB;
__device__ __forceinline__ int crow(int r,int hi){return (r&3)+8*(r>>2)+4*hi;}
#define SBAR() __builtin_amdgcn_sched_barrier(0)
__device__ __forceinline__ void cmask(f32x16&p0,f32x16&p1,int jb,int qrel,int hi){
  int d=qrel-(64*jb+4*hi); asm volatile("":"+v"(d));
  #pragma unroll
  for(int r=0;r<16;++r){const int c=(r&3)+8*(r>>2); const unsigned m0=(unsigned)((d-c)>>31), m1=(unsigned)((d-c-32)>>31);
    p0[r]=__uint_as_float((m0&0xff800000u)|(~m0&__float_as_uint(p0[r]))); p1[r]=__uint_as_float((m1&0xff800000u)|(~m1&__float_as_uint(p1[r])));}
}

constexpr bool FOX_GUARD=true;
constexpr int SKIP_LOG2=200;
constexpr int NSLOT=3, SLOTB=8192;
constexpr int LDS_K=0, LDS_V=NSLOT*SLOTB, LDS_WS=2*NSLOT*SLOTB, LDS_OST=LDS_WS+NW*64*4, LDS_ATT=LDS_OST+NW*4096, LDS_GK=LDS_ATT, LDS_BYTES=LDS_ATT+(SEQ+QB)*4;
constexpr float C2=0.125f*1.4426950408889634f;
__device__ __forceinline__ void glds16(const void*gsrc,unsigned lds_dst){unsigned keep;
  asm volatile("s_mov_b32 %0, m0\n\ts_mov_b32 m0, %2\n\ts_nop 0\n\tglobal_load_lds_dwordx4 %1, off\n\ts_mov_b32 m0, %0":"=&s"(keep):"v"(gsrc),"s"(lds_dst):"memory");}
__device__ __forceinline__ void glds4(const void*gsrc,unsigned lds_dst){unsigned keep;
  asm volatile("s_mov_b32 %0, m0\n\ts_mov_b32 m0, %2\n\ts_nop 0\n\tglobal_load_lds_dword %1, off\n\ts_mov_b32 m0, %0":"=&s"(keep):"v"(gsrc),"s"(lds_dst):"memory");}
__device__ __forceinline__ float max3f(float a,float b,float c){float r;asm("v_max3_f32 %0, %1, %2, %3":"=v"(r):"v"(a),"v"(b),"v"(c));return r;}
__device__ __forceinline__ float max2f(float a,float b){float r;asm("v_max_f32_e32 %0, %1, %2":"=v"(r):"v"(a),"v"(b));return r;}
__device__ __forceinline__ float fadd_s(float a,float b){float r;asm("v_add_f32_e32 %0, %1, %2":"=v"(r):"v"(a),"v"(b));return r;}
__device__ __forceinline__ float fsub_s(float a,float b){float r;asm("v_sub_f32_e32 %0, %1, %2":"=v"(r):"v"(a),"v"(b));return r;}
typedef float f32x2_t __attribute__((ext_vector_type(2))); typedef __bf16 bf16x2_t __attribute__((ext_vector_type(2)));
__device__ __forceinline__ unsigned cvtpk_s(float lo,float hi){f32x2_t v={lo,hi};bf16x2_t b=__builtin_convertvector(v,bf16x2_t);return __builtin_bit_cast(unsigned,b);}
#define WAIT_BAR(N) asm volatile("s_waitcnt vmcnt(" #N ") lgkmcnt(0)\n\ts_barrier":::"memory")

template<bool ACC> __device__ __forceinline__ void qkt(f32x16&p0,f32x16&p1,const char*Kslot,const bf16x8*qr,const f32x16&negm,int r32,int hi){
  const char*kb=Kslot+hi*1024+r32*16;
  #pragma unroll
  for(int d0=0;d0<4;++d0){
    const bf16x8 b0=*reinterpret_cast<const bf16x8*>(kb+d0*2048);
    const bf16x8 b1=*reinterpret_cast<const bf16x8*>(kb+d0*2048+512);
    if(d0==0&&!ACC){p0=__builtin_amdgcn_mfma_f32_32x32x16_bf16(b0,qr[0],negm,0,0,0);p1=__builtin_amdgcn_mfma_f32_32x32x16_bf16(b1,qr[0],negm,0,0,0);}
    else{p0=__builtin_amdgcn_mfma_f32_32x32x16_bf16(b0,qr[d0],p0,0,0,0);p1=__builtin_amdgcn_mfma_f32_32x32x16_bf16(b1,qr[d0],p1,0,0,0);}}
}
typedef __attribute__((address_space(3))) const char* lds_cptr;
typedef short v4i16_t __attribute__((ext_vector_type(4)));
__device__ __forceinline__ void kload8(bf16x8*kf,lds_cptr kp){
  kf[0]=*(const __attribute__((address_space(3))) bf16x8*)(kp);      kf[1]=*(const __attribute__((address_space(3))) bf16x8*)(kp+512);
  kf[2]=*(const __attribute__((address_space(3))) bf16x8*)(kp+2048); kf[3]=*(const __attribute__((address_space(3))) bf16x8*)(kp+2560);
  kf[4]=*(const __attribute__((address_space(3))) bf16x8*)(kp+4096); kf[5]=*(const __attribute__((address_space(3))) bf16x8*)(kp+4608);
  kf[6]=*(const __attribute__((address_space(3))) bf16x8*)(kp+6144); kf[7]=*(const __attribute__((address_space(3))) bf16x8*)(kp+6656);
}
__device__ __forceinline__ void kload2(bf16x8*kf,lds_cptr kp,int j){ kf[2*j]=*(const __attribute__((address_space(3))) bf16x8*)(kp+j*2048); kf[2*j+1]=*(const __attribute__((address_space(3))) bf16x8*)(kp+j*2048+512); }
__device__ __forceinline__ s16x4 vtr(lds_cptr p){ return __builtin_bit_cast(s16x4,__builtin_amdgcn_ds_read_tr16_b64_v4i16((__attribute__((address_space(3))) v4i16_t*)p)); }
__device__ __forceinline__ float rowmax(const f32x16&p0,const f32x16&p1){
  float a=max3f(p0[0],p0[1],p1[0]),b=max3f(p0[2],p0[3],p1[1]);a=max3f(a,p1[2],p1[3]);
  #pragma unroll
  for(int r=4;r<16;r+=4){a=max3f(a,p0[r],p0[r+1]);b=max3f(b,p0[r+2],p0[r+3]);a=max3f(a,p1[r],p1[r+1]);b=max3f(b,p1[r+2],p1[r+3]);}
  const float m=max2f(a,b);
  auto rr=__builtin_amdgcn_permlane32_swap(__float_as_uint(m),__float_as_uint(m),false,false);
  return max2f(__uint_as_float(rr[0]),__uint_as_float(rr[1]));
}
__device__ __forceinline__ void pv(f32x16*o,int vb,bf16x8 pa0,bf16x8 pa1,bf16x8 pa2,bf16x8 pa3){
  #pragma unroll
  for(int d0=0;d0<2;++d0){s16x4 lo[4],hi[4];
    #pragma unroll
    for(int ks=0;ks<4;++ks){
      asm volatile("ds_read_b64_tr_b16 %0,%1 offset:%c2":"=&v"(lo[ks]):"v"(vb),"i"(d0*4096+ks*1024):"memory");
      asm volatile("ds_read_b64_tr_b16 %0,%1 offset:%c2":"=&v"(hi[ks]):"v"(vb),"i"(d0*4096+ks*1024+512):"memory");}
    asm volatile("s_waitcnt lgkmcnt(0)":::"memory");SBAR();
    #define PK(k) (bf16x8){lo[k][0],lo[k][1],lo[k][2],lo[k][3],hi[k][0],hi[k][1],hi[k][2],hi[k][3]}
    o[d0]=__builtin_amdgcn_mfma_f32_32x32x16_bf16(pa0,PK(0),o[d0],0,0,0);
    o[d0]=__builtin_amdgcn_mfma_f32_32x32x16_bf16(pa1,PK(1),o[d0],0,0,0);
    o[d0]=__builtin_amdgcn_mfma_f32_32x32x16_bf16(pa2,PK(2),o[d0],0,0,0);
    o[d0]=__builtin_amdgcn_mfma_f32_32x32x16_bf16(pa3,PK(3),o[d0],0,0,0);
    #undef PK
  }
}

#ifndef ATTN_STORE16
#define ATTN_STORE16(p,v) (*(u32x4*)(p)=(v))
#endif
template<int MODE,int THRL> __device__ __forceinline__ void attn_unit(int b,int h,int qb,const bf16*Q,const bf16*__restrict__ K,const bf16*__restrict__ V,bf16*O,char*shm,const float*GKg,const unsigned long long*MKT,const int wv){
  int lane_; asm volatile("v_mbcnt_lo_u32_b32 %0, -1, 0\n\tv_mbcnt_hi_u32_b32 %0, -1, %0":"=v"(lane_)); const int wid=wv,lane=lane_,tid=wid*64+lane,r32=lane&31,hi=lane>>5;
  const long rowbase=(long)b*SEQ; const int q0=qb*QB;
  const bf16*Qw=Q+(rowbase+q0+wid*QBLK)*DM+h*D;
  int kt0=0;
  if constexpr(MODE==0){ const float*gsrc=GKg+(size_t)(b*NHEAD+h)*SEQ; const int te=2*lane; const bool live=(te<=(q0+QB)/KVBLK-4)&&(gsrc[((te+1)<(q0+QB)/KVBLK?(te+1):0)*KVBLK+KVBLK-1]-gsrc[q0]>=-(float)SKIP_LOG2);
    const unsigned long long bal=__ballot(live); const int first=bal?__builtin_ctzll(bal):0; kt0=2*first; const int cap=(q0+QB)/KVBLK-4; kt0=kt0<cap?kt0:cap; kt0=__builtin_amdgcn_readfirstlane(kt0); }
  const bf16*Kh=K+(rowbase+(long)kt0*KVBLK)*DM+h*D,*Vh=V+(rowbase+(long)kt0*KVBLK)*DM+h*D;
  const lds_cptr shm3=(lds_cptr)shm;
  const unsigned lds0=(unsigned)(uintptr_t)shm;
  float*wsf=(float*)(shm+LDS_WS)+wid*64;
  const bf16*ksrc=Kh+(long)lane*DM+wid*8;
  const bf16*vsrc=Vh+(long)(16*(wid&3)+(lane>>2))*DM+(wid>>2)*32+(lane&3)*8;
  const unsigned kdst=lds0+LDS_K+wid*1024, vdst=lds0+LDS_V+wid*1024;
  #define DMA_K(t,slot) glds16(ksrc+(long)(t)*KVBLK*DM,(unsigned)__builtin_amdgcn_readfirstlane(kdst+(slot)))
  #define DMA_V(t,slot) glds16(vsrc+(long)(t)*KVBLK*DM,(unsigned)__builtin_amdgcn_readfirstlane(vdst+(slot)))
  const int vb0=(int)(lds0+LDS_V)+((lane>>4)&1)*32+(lane&3)*8+(4*hi+((lane&15)>>2))*64;
  const char*Kbase=shm+LDS_K; bf16x8 kf[8];
  const lds_cptr kp0=shm3+LDS_K+hi*1024+r32*16; const lds_cptr vp0=shm3+LDS_V+((lane>>4)&1)*32+(lane&3)*8+(4*hi+((lane&15)>>2))*64;
  const int NT=(q0+QB)/KVBLK-kt0;
  const int qrel=wid*QBLK+r32;
  #define MLOAD(t) glds4(msrc+(size_t)(t)*(SEQ*2),(unsigned)__builtin_amdgcn_readfirstlane(mdst+(((t)&1)<<8)))
  #define APPLY(P0,P1,tt) do{ if constexpr(MODE==1){ unsigned long long w_=*(const __attribute__((address_space(3))) unsigned long long*)(shm3+LDS_GK+wid*512+(((tt)&1)<<8)+r32*8); \
      w_=((tt)<=((q0+qrel)>>6))?w_:0ull; w_>>=(4*hi); const unsigned ml_=(unsigned)w_, mh_=(unsigned)(w_>>32); \
      _Pragma("unroll") for(int r=0;r<16;++r){ const int ps_=(r&3)+8*(r>>2); \
        P0[r]=__uint_as_float(__float_as_uint(P0[r])&(unsigned)__builtin_amdgcn_sbfe((int)ml_,ps_,1)); P1[r]=__uint_as_float(__float_as_uint(P1[r])&(unsigned)__builtin_amdgcn_sbfe((int)mh_,ps_,1)); } } }while(0)
  #define LOADBIAS(X0,X1,tt) do{ if constexpr(MODE==0){ const lds_f4p g_=(lds_f4p)(shm3+LDS_GK+16*hi)+(tt)*16; \
      _Pragma("unroll") for(int g4=0;g4<4;++g4){ const f32x4v a_=g_[2*g4], b_=g_[8+2*g4]; \
        _Pragma("unroll") for(int i_=0;i_<4;++i_){ X0[4*g4+i_]=a_[i_]; X1[4*g4+i_]=b_[i_]; } } } }while(0)
  #define CINIT(X) (*(MODE==0?&(X):&negm))
  typedef __attribute__((address_space(3))) const f32x4v* lds_f4p;
  const unsigned*msrc=nullptr; unsigned mdst=0u;
  if constexpr(MODE==1){ msrc=(const unsigned*)(MKT+(size_t)b*(SEQ/KVBLK)*SEQ+(q0+wid*QBLK+(lane>>1)))+(lane&1); mdst=lds0+LDS_GK+wid*512; MLOAD(0); }
  if constexpr(MODE==0){
    const float*src=GKg+(size_t)(b*NHEAD+h)*SEQ; const float ref=src[q0+QB-1];   __attribute__((address_space(3))) float*gk=(__attribute__((address_space(3))) float*)(shm3+LDS_GK);
    for(int i=tid*4;i<q0+QB-kt0*KVBLK;i+=NW*64*4){ f32x4v v=*(const f32x4v*)(src+kt0*KVBLK+i); v=v-ref; *(__attribute__((address_space(3))) f32x4v*)(gk+i)=v; }
  }
  DMA_K(0,0);DMA_V(0,0);DMA_K(1,SLOTB);
  bf16x8 qr[4];
  #pragma unroll
  for(int d0=0;d0<4;++d0)qr[d0]=*reinterpret_cast<const bf16x8*>(&Qw[(long)r32*DM+d0*16+hi*8]);
  float mhat=0.f,l_reg=0.f;f32x16 o[2];o[0]=f32x16{};o[1]=f32x16{};f32x16 negm=f32x16{};if constexpr(MODE!=0){asm volatile("":"+v"(negm));}
  #define CMASK(P0,P1,t) do{ if constexpr(MODE==0){ int jb_=(t)-(NT-4); if(jb_>=0)cmask(P0,P1,jb_,qrel,hi);} }while(0)
  bool resc=false; bool mflag=false; constexpr int THR0=64;
  if constexpr(MODE==0){
    const float*gs_=GKg+(size_t)(b*NHEAD+h)*SEQ; const float span=gs_[q0+QB-1]-gs_[q0];
    if(__builtin_amdgcn_readfirstlane(span>100.f?1:0)){ mflag=true; mhat=-(gs_[q0+QB-1]-gs_[q0+wid*QBLK+QBLK-1]); } }
  #define START(P0,P1) do{ resc=false; if constexpr(MODE==0&&!FOX_GUARD){} else { const float rm=rowmax(P0,P1); \
    if constexpr(MODE==0){ if(__builtin_expect(__any(rm>(float)THR0),0)){ mhat+=__builtin_fmaxf(rm,0.f); mflag=true; } \
      if(mflag){ _Pragma("unroll") for(int r=0;r<16;++r){P0[r]=fsub_s(P0[r],mhat);P1[r]=fsub_s(P1[r],mhat);} } } \
    else { const float dl=rm; mhat=fadd_s(mhat,dl); \
      _Pragma("unroll") for(int r=0;r<16;++r){P0[r]=fsub_s(P0[r],dl);P1[r]=fsub_s(P1[r],dl);} \
      _Pragma("unroll") for(int r=0;r<16;++r)negm[r]=-mhat; asm volatile("":"+v"(negm)); } } \
    _Pragma("unroll") for(int r=0;r<16;++r)P0[r]=__builtin_amdgcn_exp2f(P0[r]); }while(0)
  #define RESC() do{ if(resc){ asm volatile("s_waitcnt lgkmcnt(0)":::"memory"); \
      _Pragma("unroll") for(int d_=0;d_<2;++d_) _Pragma("unroll") for(int r=0;r<16;++r)o[d_][r]*=wsf[crow(r,hi)]; } }while(0)
  f32x16 pA0,pA1,pB0,pB1;
  int sl_prev=0,sl_cur=0,sl_next=SLOTB;
  #define ROT() do{sl_prev=sl_cur;sl_cur=sl_next;sl_next=(sl_next==(NSLOT-1)*SLOTB)?0:sl_next+SLOTB;}while(0)
  DMA_K(2,2*SLOTB);
  WAIT_BAR(3);
  LOADBIAS(pA0,pA1,0); qkt<MODE==0>(pA0,pA1,Kbase,qr,negm,r32,hi);asm volatile("s_nop 15\n\ts_nop 7":"+v"(pA0),"+v"(pA1));CMASK(pA0,pA1,0);
  START(pA0,pA1);
  _Pragma("unroll") for(int r=0;r<16;++r)pA1[r]=__builtin_amdgcn_exp2f(pA1[r]);
  LOADBIAS(pB0,pB1,1);
  WAIT_BAR(0);
  DMA_K(3,0);DMA_V(1,SLOTB);
  ROT();
  kload8(kf,kp0+sl_cur);
  WAIT_BAR(2);
  s16x4 vlo[8],vhi[8]; u32x4 pw0,pw1,pw2,pw3;
  #define PKW(P,B) cvtpk_s(P[B],P[B+1])
  #define PAF(k) __builtin_bit_cast(bf16x8,pw##k)
  #define VFR(i) (bf16x8){vlo[i][0],vlo[i][1],vlo[i][2],vlo[i][3],vhi[i][0],vhi[i][1],vhi[i][2],vhi[i][3]}
  #define PIN(x) asm volatile("":"+v"(x))
  #define MX3(a,b,c) __builtin_fmaxf(__builtin_fmaxf((a),(b)),(c))
  #define GAPA(MF,A0,A1,A2,A3,W0,W1,PW) do{ MF; sacc+=A0; sacc+=A1; sacc+=A2; sacc+=A3; PIN(sacc); W0; W1; PIN(PW); SBAR(); }while(0)
  #define EX(v) __builtin_amdgcn_exp2f(v)
  #define GAPB(MF,X,B) do{ MF; X[B]=EX(X[B]); X[B+1]=EX(X[B+1]); X[B+2]=EX(X[B+2]); X[B+3]=EX(X[B+3]); PIN(X); SBAR(); }while(0)
  #define VRD(i) do{ vlo[i]=vtr(vp_+(((i)>>2)*4096+((i)&3)*1024)); vhi[i]=vtr(vp_+(((i)>>2)*4096+((i)&3)*1024+512)); }while(0)
  #define KRD(G,j) do{ if(G){ kload2(kf,kp0+sl_next,j); SBAR(); } }while(0)
  #define STEP(C0,C1,P0,P1,t,GK,GV,GL) do{ SBAR(); if constexpr(MODE==1){ APPLY(P0,P1,(t)-1); MLOAD(t); SBAR(); } \
    const lds_cptr vp_=vp0+sl_prev; \
    VRD(0); SBAR(); float sacc=(P0[0]+P0[1]); \
    GAPA(C0=__builtin_amdgcn_mfma_f32_32x32x16_bf16(kf[0],qr[0],CINIT(C0),0,0,0), P0[2],P0[3],P0[4],P0[5],     pw0[0]=PKW(P0,0), pw0[1]=PKW(P0,2), pw0); \
    VRD(4); SBAR(); GAPA(C1=__builtin_amdgcn_mfma_f32_32x32x16_bf16(kf[1],qr[0],CINIT(C1),0,0,0), P0[6],P0[7],P0[8],P0[9],     pw0[2]=PKW(P0,4), pw0[3]=PKW(P0,6), pw0); \
    VRD(1); SBAR(); GAPA(C0=__builtin_amdgcn_mfma_f32_32x32x16_bf16(kf[2],qr[1],C0,0,0,0),   P0[10],P0[11],P0[12],P0[13], pw1[0]=PKW(P0,8), pw1[1]=PKW(P0,10), pw1); \
    VRD(5); SBAR(); GAPA(C1=__builtin_amdgcn_mfma_f32_32x32x16_bf16(kf[3],qr[1],C1,0,0,0),   P0[14],P0[15],P1[0],P1[1],   pw1[2]=PKW(P0,12),pw1[3]=PKW(P0,14), pw1); \
    VRD(2); SBAR(); GAPA(C0=__builtin_amdgcn_mfma_f32_32x32x16_bf16(kf[4],qr[2],C0,0,0,0),   P1[2],P1[3],P1[4],P1[5],     pw2[0]=PKW(P1,0), pw2[1]=PKW(P1,2), pw2); \
    VRD(6); SBAR(); GAPA(C1=__builtin_amdgcn_mfma_f32_32x32x16_bf16(kf[5],qr[2],C1,0,0,0),   P1[6],P1[7],P1[8],P1[9],     pw2[2]=PKW(P1,4), pw2[3]=PKW(P1,6), pw2); \
    VRD(3); SBAR(); GAPA(C0=__builtin_amdgcn_mfma_f32_32x32x16_bf16(kf[6],qr[3],C0,0,0,0),   P1[10],P1[11],P1[12],P1[13], pw3[0]=PKW(P1,8), pw3[1]=PKW(P1,10), pw3); \
    VRD(7); SBAR(); GAPA(C1=__builtin_amdgcn_mfma_f32_32x32x16_bf16(kf[7],qr[3],C1,0,0,0),   P1[14],P1[15],0.f,0.f,       pw3[2]=PKW(P1,12),pw3[3]=PKW(P1,14), pw3); \
    l_reg+=sacc; if constexpr(MODE==0){ if((t)+1<NT){ LOADBIAS(P0,P1,(t)+1); } } \
    if(GK){DMA_K((t)+3,sl_cur);} if(GV){DMA_V((t)+1,sl_next);} \
    CMASK(C0,C1,t); \
    if constexpr(MODE==0&&!FOX_GUARD){ resc=false; asm volatile("":"+v"(C0),"+v"(C1)); } else \
    { float a=MX3(C0[0],C0[1],C1[0]),b=MX3(C0[2],C0[3],C1[1]); a=MX3(a,C1[2],C1[3]); \
      _Pragma("unroll") for(int r=4;r<16;r+=4){a=MX3(a,C0[r],C0[r+1]);b=MX3(b,C0[r+2],C0[r+3]);a=MX3(a,C1[r],C1[r+1]);b=MX3(b,C1[r+2],C1[r+3]);} \
      float rm=__builtin_fmaxf(a,b); { auto rr=__builtin_amdgcn_permlane32_swap(__float_as_uint(rm),__float_as_uint(rm),false,false); rm=__builtin_fmaxf(__uint_as_float(rr[0]),__uint_as_float(rr[1])); } \
      resc=false; \
      if constexpr(MODE==0){ rm-=mhat; \
        if(__builtin_expect(__any(rm>(float)THR0),0)){ const float dl=__builtin_fmaxf(rm,0.f); mhat+=dl; mflag=true; \
          const float f=__builtin_amdgcn_exp2f(-dl); l_reg*=f; if(hi==0)wsf[r32]=f; resc=true; } \
        if(mflag){ _Pragma("unroll") for(int r=0;r<16;++r){C0[r]-=mhat;C1[r]-=mhat;} } } \
      else if(__builtin_expect(__any(rm>(float)THRL),0)){ const float dl=__builtin_fmaxf(rm,0.f); mhat+=dl; \
        _Pragma("unroll") for(int r=0;r<16;++r){C0[r]-=dl;C1[r]-=dl;} \
        _Pragma("unroll") for(int r=0;r<16;++r)negm[r]=-mhat; asm volatile("":"+v"(negm)); \
        const float f=__builtin_amdgcn_exp2f(-dl); l_reg*=f; if(hi==0)wsf[r32]=f; resc=true; } } \
    SBAR(); \
    GAPB(o[0]=__builtin_amdgcn_mfma_f32_32x32x16_bf16(PAF(0),VFR(0),o[0],0,0,0), C0,0); \
    GAPB(o[1]=__builtin_amdgcn_mfma_f32_32x32x16_bf16(PAF(0),VFR(4),o[1],0,0,0), C0,4); \
    KRD(GL,0); GAPB(o[0]=__builtin_amdgcn_mfma_f32_32x32x16_bf16(PAF(1),VFR(1),o[0],0,0,0), C0,8); \
    KRD(GL,1); GAPB(o[1]=__builtin_amdgcn_mfma_f32_32x32x16_bf16(PAF(1),VFR(5),o[1],0,0,0), C0,12); \
    KRD(GL,2); GAPB(o[0]=__builtin_amdgcn_mfma_f32_32x32x16_bf16(PAF(2),VFR(2),o[0],0,0,0), C1,0); \
    KRD(GL,3); GAPB(o[1]=__builtin_amdgcn_mfma_f32_32x32x16_bf16(PAF(2),VFR(6),o[1],0,0,0), C1,4); \
    GAPB(o[0]=__builtin_amdgcn_mfma_f32_32x32x16_bf16(PAF(3),VFR(3),o[0],0,0,0), C1,8); \
    GAPB(o[1]=__builtin_amdgcn_mfma_f32_32x32x16_bf16(PAF(3),VFR(7),o[1],0,0,0), C1,12); \
    }while(0)
  int t=1;
  #undef CMASK
  #define CMASK(P0,P1,t) do{}while(0)
  for(;t+5<NT;t+=2){
    STEP(pB0,pB1,pA0,pA1,t,true,true,true);     WAIT_BAR(2); RESC(); ROT();
    STEP(pA0,pA1,pB0,pB1,t+1,true,true,true);   WAIT_BAR(2); RESC(); ROT();
  }
  #undef CMASK
  #define CMASK(P0,P1,t) do{ if constexpr(MODE==0){ int jb_=(t)-(NT-4); if(jb_>=0)cmask(P0,P1,jb_,qrel,hi);} }while(0)
  #define ENDW(tt) do{ if((tt)+3<NT){WAIT_BAR(2);} else if((tt)+2<NT){WAIT_BAR(1);} else {WAIT_BAR(0);} }while(0)
  for(;t+1<NT;t+=2){
    STEP(pB0,pB1,pA0,pA1,t,(t+3<NT),(t+1<NT),(t+1<NT));       ENDW(t);   RESC(); ROT();
    STEP(pA0,pA1,pB0,pB1,t+1,(t+4<NT),(t+2<NT),(t+2<NT));     ENDW(t+1); RESC(); ROT();
  }
  STEP(pB0,pB1,pA0,pA1,NT-1,false,false,false); RESC();
  if constexpr(MODE==1){ asm volatile("s_waitcnt vmcnt(0)":::"memory"); APPLY(pB0,pB1,NT-1); }
  { float sacc=pB0[0]+pB0[1]; _Pragma("unroll") for(int r=2;r<16;++r)sacc+=pB0[r]; _Pragma("unroll") for(int r=0;r<16;++r)sacc+=pB1[r]; l_reg+=sacc;
    pw0=(u32x4){PKW(pB0,0),PKW(pB0,2),PKW(pB0,4),PKW(pB0,6)};pw1=(u32x4){PKW(pB0,8),PKW(pB0,10),PKW(pB0,12),PKW(pB0,14)};pw2=(u32x4){PKW(pB1,0),PKW(pB1,2),PKW(pB1,4),PKW(pB1,6)};pw3=(u32x4){PKW(pB1,8),PKW(pB1,10),PKW(pB1,12),PKW(pB1,14)};
    SBAR(); pv(o,vb0+sl_cur,PAF(0),PAF(1),PAF(2),PAF(3)); }
  #undef PKW
  #undef PAF
  #undef VFR
  #undef PIN
  #undef MX3
  #undef GAPA
  #undef GAPB
  #undef EX
  #undef VRD
  #undef KRD
  #undef STEP
  #undef ENDW
  {auto rr=__builtin_amdgcn_permlane32_swap(__float_as_uint(l_reg),__float_as_uint(l_reg),false,false);l_reg=__uint_as_float(rr[0])+__uint_as_float(rr[1]);}
  if(hi==0)wsf[32+r32]=l_reg;asm volatile("s_waitcnt lgkmcnt(0)":::"memory");
  float rli[16];
  #pragma unroll
  for(int r=0;r<16;++r)rli[r]=__builtin_amdgcn_rcpf(wsf[32+crow(r,hi)]);
  unsigned char*Ow=(unsigned char*)O+(rowbase+q0+wid*QBLK)*DM+h*D;
  { __attribute__((address_space(3))) unsigned char*stg=(__attribute__((address_space(3))) unsigned char*)(shm3+LDS_OST)+wid*2048;
    #pragma unroll
    for(int r=0;r<16;++r){const int orow=crow(r,hi); const int w2=__builtin_amdgcn_cvt_pk_fp8_f32(o[0][r]*rli[r],o[1][r]*rli[r],0,false);
      stg[orow*64+r32]=(unsigned char)(w2&0xff); stg[orow*64+32+r32]=(unsigned char)((w2>>8)&0xff);}
    asm volatile("s_waitcnt lgkmcnt(0)":::"memory");
    #pragma unroll
    for(int i=0;i<2;++i){const int row=i*16+(lane>>2),ch=lane&3; const u32x4 v=*(const __attribute__((address_space(3))) u32x4*)(stg+row*64+ch*16); ATTN_STORE16(Ow+(long)row*DM+ch*16,v);} }
  asm volatile("s_waitcnt lgkmcnt(0)\n\ts_barrier":::"memory");
  #undef DMA_K
  #undef MLOAD
  #undef APPLY
  #undef LOADBIAS
  #undef CINIT
  #undef DMA_V
  #undef CMASK
  #undef START
  #undef RESC
  #undef ROT
}
constexpr int ATTN_LDS_BYTES=LDS_BYTES;
struct AttnTensors { const bf16* Q; const bf16* K; const bf16* V; bf16* O; const float* GK; const unsigned long long* MK; };
struct AttnUnit { int bh; int qb; };
struct StaticOrder {
  int vcu;
  __device__ __forceinline__ explicit StaticOrder(int grid,int block):vcu((block%8)*(grid/8)+block/8){}
  __device__ __forceinline__ bool next(int i,AttnUnit&u)const{ if(i>=4)return false; const int s=vcu&7; u.bh=vcu>>3; u.qb=(i==0)?s:(i==1)?15-s:(i==2)?16+s:31-s; return true; }
  __device__ __forceinline__ void a_ready(const AttnUnit&)const{}
  __device__ __forceinline__ void done(const AttnUnit&)const{}
};
template<int MODE,class Sched,int THRL=8> __device__ __forceinline__ void attn_phase(char*lds,const AttnTensors&T,const Sched&S,const int wv){
  AttnUnit u;
  for(int i=0;S.next(i,u);++i){ S.a_ready(u); attn_unit<MODE,THRL>(u.bh/NHEAD,u.bh%NHEAD,u.qb,T.Q,T.K,T.V,T.O,lds,T.GK,T.MK,wv); S.done(u); }
}
template<int MODE,int THRL=8> __device__ __forceinline__ void attn_phase_queue(char*lds,const AttnTensors&T,unsigned*head,volatile __attribute__((address_space(3))) unsigned*slot,const int wv,const bool tid0){
  constexpr int NUNITS=BATCH*NHEAD*NQB;
  for(;;){
    if(tid0){ *slot=__hip_atomic_fetch_add(head,1u,__ATOMIC_RELAXED,__HIP_MEMORY_SCOPE_AGENT); }
    asm volatile("s_waitcnt vmcnt(0) lgkmcnt(0)\n\ts_barrier":::"memory");
    const int idx=__builtin_amdgcn_readfirstlane((int)*slot);
    if(idx>=NUNITS)break;
    const int qb=NQB-1-idx/(BATCH*NHEAD), bh=idx%(BATCH*NHEAD);
    attn_unit<MODE,THRL>(bh/NHEAD,bh%NHEAD,qb,T.Q,T.K,T.V,T.O,lds,T.GK,T.MK,wv);
  }
}
#undef SBAR
#undef WAIT_BAR
}
#define GAS __attribute__((address_space(1)))
#define LAS __attribute__((address_space(3)))
__device__ __forceinline__ int lane_id_v() { int l; asm volatile("v_mbcnt_lo_u32_b32 %0, -1, 0\n\tv_mbcnt_hi_u32_b32 %0, -1, %0" : "=v"(l)); return l; }
typedef unsigned short bf16;
typedef unsigned v4u __attribute__((ext_vector_type(4)));
typedef float f32x4 __attribute__((ext_vector_type(4)));
typedef short bf16x8 __attribute__((ext_vector_type(8)));
typedef GAS unsigned gu32;
typedef GAS unsigned long long gu64;
#define RLX_AGENT __ATOMIC_RELAXED, __HIP_MEMORY_SCOPE_AGENT
#define LDS_WAIT() asm volatile("s_waitcnt lgkmcnt(0)" ::: "memory")
#define VM_WAIT() asm volatile("s_waitcnt vmcnt(0)" ::: "memory")
__device__ __forceinline__ unsigned long long rt() { return __builtin_amdgcn_s_memrealtime(); }
__device__ __forceinline__ unsigned f2bf(float f) { unsigned u = __builtin_bit_cast(unsigned, f); return (u + 0x7fffu + ((u >> 16) & 1u)) >> 16; }
__device__ __forceinline__ unsigned pk2(float lo, float hi) { return f2bf(lo) | (f2bf(hi) << 16); }

#define XB_TMO      128
#define XB_XCNT(j)  (256  + 64 * (j))
#define XB_XSUB(j)  (1280 + 64 * (j))
#define XB_XGEN(j)  (2304 + 64 * (j))
#define XB_TOP      3328
#define XB_TOPGEN   3392
#define XCD_BAR_WORDS 3456
#define XB_SPIN_CAP (1u << 18)

__device__ __forceinline__ unsigned xb_ld(unsigned* p)              { return __hip_atomic_load(p, __ATOMIC_RELAXED, __HIP_MEMORY_SCOPE_AGENT); }
__device__ __forceinline__ unsigned xb_add(unsigned* p, unsigned v) { return __hip_atomic_fetch_add(p, v, __ATOMIC_RELAXED, __HIP_MEMORY_SCOPE_AGENT); }
__device__ __forceinline__ unsigned xb_xcc_id() { return (unsigned)__builtin_amdgcn_s_getreg((3 << 11) | 20) & 0xFu; }
#define XB_SPIN(cond, bar) do { unsigned _sp = 0; while (cond) { __builtin_amdgcn_s_sleep(1); \
    if ((++_sp & 255u) == 0u) { if (xb_ld(&(bar)[XB_TMO])) break; if (_sp > XB_SPIN_CAP) { atomicAdd(&(bar)[XB_TMO], 1u); break; } } } } while (0)

struct XcdBarrier {
    unsigned* bar; unsigned x;
    volatile LAS unsigned* st;
};

__device__ __forceinline__ XcdBarrier xcd_barrier_post(unsigned* bar, volatile LAS unsigned* st, bool tid0) {
    XcdBarrier b; b.bar = bar; b.x = xb_xcc_id(); b.st = st;
    if (tid0) (void)xb_add(&bar[XB_XCNT(b.x)], 1u);
    return b;
}
__device__ __forceinline__ void xcd_barrier_complete(unsigned* bar, unsigned x, unsigned& nloc, unsigned& nx) {
    const unsigned G = gridDim.x * gridDim.y * gridDim.z;
    unsigned sum, cnt, mine, sp = 0u;
    for (;;) {
        sum = 0u; cnt = 0u; mine = 0u;
#pragma unroll
        for (unsigned j = 0; j < 16; ++j) { const unsigned c = xb_ld(&bar[XB_XCNT(j)]); sum += c; cnt += (c > 0u) ? 1u : 0u; mine = (j == x) ? c : mine; }
        if (sum == G) break;
        __builtin_amdgcn_s_sleep(1);
        if ((++sp & 255u) == 0u) { if (xb_ld(&bar[XB_TMO])) break; if (sp > XB_SPIN_CAP) { atomicAdd(&bar[XB_TMO], 1u); break; } }
    }
    nloc = mine > 0u ? mine : 1u; nx = cnt > 0u ? cnt : 1u;
}

__device__ __forceinline__ void xcd_barrier(const XcdBarrier& b, bool tid0) {
    asm volatile("s_waitcnt vmcnt(0)" ::: "memory");
    __syncthreads();
    if (tid0) {
        unsigned* bar = b.bar;
        __builtin_amdgcn_s_waitcnt(0);
        unsigned nloc = b.st[0], nx = b.st[1];
        if (nloc == 0u) { xcd_barrier_complete(bar, b.x, nloc, nx); b.st[0] = nloc; b.st[1] = nx; }
        const unsigned old = xb_add(&bar[XB_XSUB(b.x)], 1u);
        const unsigned gen = old / nloc;
        if (old + 1u == (gen + 1u) * nloc) {
            __builtin_amdgcn_fence(__ATOMIC_RELEASE, "agent");
            asm volatile("s_waitcnt vmcnt(0)" ::: "memory");
            const unsigned og = xb_add(&bar[XB_TOP], 1u);
            const unsigned tg = og / nx;
            if (og + 1u == (tg + 1u) * nx) xb_add(&bar[XB_TOPGEN], 1u);
            else XB_SPIN(xb_ld(&bar[XB_TOPGEN]) == tg, bar);
            __builtin_amdgcn_fence(__ATOMIC_ACQUIRE, "agent");
            xb_add(&bar[XB_XGEN(b.x)], 1u);
            asm volatile("s_waitcnt vmcnt(0)" ::: "memory");
        } else {
            XB_SPIN(xb_ld(&bar[XB_XGEN(b.x)]) == gen, bar);
            __builtin_amdgcn_fence(__ATOMIC_ACQUIRE, "agent");
            asm volatile("s_waitcnt vmcnt(0)" ::: "memory");
        }
    }
    __syncthreads();
}
constexpr int NWAVES = 8;
#ifndef MK_ONE_LAUNCH
#define MK_ONE_LAUNCH 1
#endif
constexpr int BATCH = 2, SEQ = 8192, D = 1024, M = BATCH * SEQ, NH = 16, HD = 64, IDXH = 8, IDXD = 64, DFF = 2816, NEXP = 8, KSEL = 256;
constexpr int AIN_N = 3 * D + IDXH * IDXD + IDXD + IDXH;
constexpr int AIN_NP = 3840;
constexpr int KVQ_NP = 3328;
constexpr int SORT_ROWS = 2 * M + NEXP * 256;
constexpr float C2 = 0.125f * 1.4426950408889634f;
constexpr float LOG2E = 1.4426950408889634f;
constexpr size_t MiB = 1u << 20;
constexpr size_t WS_CTL = 0, CTL_ZERO_BYTES = 96 * 1024;
constexpr size_t WS_COS = 1 * MiB, WS_SIN = 2 * MiB;
constexpr size_t WS_SSQ = 3 * MiB;
constexpr size_t WS_WI = 4 * MiB;
constexpr size_t WS_LOGF = 5 * MiB;
constexpr size_t WS_GK = 6 * MiB;
constexpr size_t WS_TOK = 7 * MiB;
constexpr size_t WS_RSD = 8 * MiB;
constexpr size_t WS_GATE = 9 * MiB;
constexpr size_t WS_KI = 10 * MiB;
constexpr size_t WS_W = 16 * MiB;
constexpr size_t W_AIN = WS_W, W_AIN_SZ = (size_t)AIN_NP * D * 2;
constexpr size_t W_AOUT = W_AIN + 2 * W_AIN_SZ, W_SQ_SZ = (size_t)D * D * 2;
constexpr size_t W_KVQ = W_AOUT + 2 * W_SQ_SZ, W_KVQ_SZ = (size_t)KVQ_NP * D * 2;
constexpr size_t W_BQ3 = W_KVQ + W_KVQ_SZ;
constexpr size_t W_BOUT = W_BQ3 + W_SQ_SZ;
constexpr size_t W_DGU = W_BOUT + 2 * W_SQ_SZ, W_GU_SZ = (size_t)2 * DFF * D * 2;
constexpr size_t W_DDN = W_DGU + 2 * W_GU_SZ, W_DN_SZ = (size_t)D * DFF * 2;
constexpr size_t W_MGU = W_DDN + 2 * W_DN_SZ;
constexpr size_t W_MDN = W_MGU + 16 * W_GU_SZ;
constexpr size_t W_END = W_MDN + 16 * W_DN_SZ;
constexpr size_t W_GU8_SZ = (size_t)2 * DFF * D, W_DN8_SZ = (size_t)D * DFF;
constexpr size_t W_AIN8_SZ = (size_t)AIN_NP * D, W_SQ8_SZ = (size_t)D * D;
constexpr size_t W_AINX_OFF = (size_t)3 * D * D;
constexpr float GU_PRESCALE = 64.0f, DN_PRESCALE = 256.0f, IN_PRESCALE = 64.0f, OUT_PRESCALE = 128.0f;
static_assert(W_END <= 352 * MiB, "weights region");
constexpr size_t WS_HB = 352 * MiB;
constexpr size_t WS_Q = 384 * MiB, WS_K = 416 * MiB, WS_V = 448 * MiB;
constexpr size_t WS_QI = 480 * MiB;
constexpr size_t WS_MASK = 496 * MiB;
constexpr size_t WS_SC = 512 * MiB;
constexpr size_t WS_ACT = 768 * MiB;
constexpr size_t WS_ASORT = 960 * MiB;
constexpr size_t WS_Y = 1028 * MiB;
constexpr size_t WS_O = 1100 * MiB;
constexpr size_t WS_H2 = 1132 * MiB;
constexpr size_t WS_HB8 = 1196 * MiB;
constexpr size_t WS_END = 1212 * MiB;
static_assert(WS_ACT + (size_t)SORT_ROWS * DFF * 2 <= WS_ASORT && WS_ASORT + (size_t)SORT_ROWS * D * 2 <= WS_Y && WS_Y + (size_t)SORT_ROWS * D * 2 <= WS_END, "ws map");
constexpr int CW_BAR = 4096;
constexpr int CW_AQ = 16384 + 256;
constexpr int CW_CNT = 16384;
constexpr int RING_OFF = 0, RING_BYTES = 131072;
constexpr int LDSCTL_OFF = RING_BYTES, MISC_OFF = LDSCTL_OFF + 320;
constexpr int LDS_BYTES = 163840;

typedef unsigned short bf16;
typedef unsigned v4u __attribute__((ext_vector_type(4)));
typedef unsigned v2u __attribute__((ext_vector_type(2)));
using pg8::pkbf;

struct Frame {
    LAS unsigned char* lds;
    volatile LAS unsigned* MISC;
    gu32* ctl;
    int tid, lane, wave, vcu, G, dry;
    unsigned char* ws;
};
__device__ __forceinline__ float wave_sum(float v) {
#pragma unroll
    for (int o = 1; o < 64; o <<= 1) v += __shfl_xor(v, o);
    return v;
}
__device__ __forceinline__ float bf2f(unsigned short b) { return __uint_as_float((unsigned)b << 16); }

__device__ __forceinline__ int map_col(int map, int n) {
    if (map == 1) { const bool plain = (n >= 2048 && n < 3072) || n >= 3648; if (plain) return n; const int d = n & 63; return (n & ~63) + 8 * ((d & 31) >> 2) + (d & 3) + 4 * (d >> 5); }
    if (map == 3) { if (n >= 576) return n; const int d = n & 63; return (n & ~63) + 8 * ((d & 31) >> 2) + (d & 3) + 4 * (d >> 5); }
    if (map == 2) { const int j = n < DFF ? n : n - DFF; return 8 * (j >> 2) + (j & 3) + (n < DFF ? 0 : 4); }
    return n;
}
__device__ const float INVF_TAB[32] = {1.000000000e+00f, 7.498942018e-01f, 5.623413324e-01f, 4.216965139e-01f, 3.162277639e-01f, 2.371373773e-01f, 1.778279394e-01f, 1.333521456e-01f, 1.000000015e-01f, 7.498942316e-02f, 5.623413250e-02f, 4.216964915e-02f, 3.162277490e-02f, 2.371373773e-02f, 1.778279431e-02f, 1.333521400e-02f, 9.999999776e-03f, 7.498942316e-03f, 5.623413250e-03f, 4.216964822e-03f, 3.162277630e-03f, 2.371373819e-03f, 1.778279431e-03f, 1.333521446e-03f, 1.000000047e-03f, 7.498941850e-04f, 5.623413017e-04f, 4.216965172e-04f, 3.162277571e-04f, 2.371373703e-04f, 1.778279402e-04f, 1.333521504e-04f};
struct Args { const float* in[17]; float* out; unsigned char* ws; int ph_lo, ph_hi, li, pad; };
typedef const volatile __attribute__((address_space(4))) Args* KArgs;
enum { I_X = 0, I_ANORM, I_AWIN, I_AWOUT, I_KVNORM, I_WKV, I_BF, I_BNORM, I_BWQ, I_BWOUT, I_FFNNORM, I_DGU, I_DDN, I_ROUTER, I_MGU, I_MDN, I_FNORM };

struct KIn { KArgs ap; __device__ __forceinline__ const float* operator[](int i) const { return (const float*)ap->in[i]; } };
constexpr int IT_AINQ = (D / 64) * (3 * D / 64), IT_AINX = (D / 64) * ((AIN_N - 3 * D + 63) / 64), IT_AIN = IT_AINQ + IT_AINX;
constexpr int IT_SQ = (D / 64) * (D / 64);
constexpr int IT_KV = (D / 64) * (2 * D / 64);
constexpr int IT_KVF = (D / 64) * 1;
constexpr int IT_GU = (D / 64) * (2 * DFF / 64);
constexpr int IT_DN = (DFF / 64) * (D / 64);
constexpr int CV_SEG0 = IT_AIN;
constexpr int CV_SEG1 = CV_SEG0 + IT_SQ + IT_GU + IT_DN + IT_AIN + IT_SQ + 8 * IT_GU + 8 * IT_DN;
constexpr int CV_SCORES = 12288;
constexpr int CV_MID0 = CV_SEG0 + CV_SCORES, CV_MID1 = CV_SEG1 + CV_SCORES;
constexpr int CV_SEG2 = CV_SEG1 + IT_KV + IT_KVF + 2 * IT_SQ + 2 * IT_SQ + IT_GU + IT_DN + 8 * IT_GU + 8 * IT_DN;
struct ConvDesc { const float* W; unsigned char* WT; const float* gain; int K, N, ncols, col_off, row_off, map, item; float wmul; bool f8; };
__device__ __forceinline__ ConvDesc conv_desc(const KIn& in, unsigned char* ws, int r) {
    int job, p = 0;
    if (r < IT_AIN) job = 0;
    else if ((r -= IT_AIN) < IT_SQ) job = 1;
    else if ((r -= IT_SQ) < IT_GU) job = 2;
    else if ((r -= IT_GU) < IT_DN) job = 3;
    else if ((r -= IT_DN) < IT_AIN) { job = 0; p = 1; }
    else if ((r -= IT_AIN) < IT_SQ) { job = 1; p = 1; }
    else if ((r -= IT_SQ) < 8 * IT_GU) { job = 4; p = r / IT_GU; r -= p * IT_GU; }
    else if ((r -= 8 * IT_GU) < 8 * IT_DN) { job = 5; p = r / IT_DN; r -= p * IT_DN; }
    else if ((r -= 8 * IT_DN) < IT_KV) job = 6;
    else if ((r -= IT_KV) < IT_KVF) job = 7;
    else if ((r -= IT_KVF) < IT_SQ) job = 8;
    else if ((r -= IT_SQ) < IT_SQ) job = 9;
    else if ((r -= IT_SQ) < 2 * IT_SQ) { job = 10; p = r / IT_SQ; r -= p * IT_SQ; }
    else if ((r -= 2 * IT_SQ) < IT_GU) { job = 2; p = 1; }
    else if ((r -= IT_GU) < IT_DN) { job = 3; p = 1; }
    else if ((r -= IT_DN) < 8 * IT_GU) { job = 4; p = r / IT_GU; r -= p * IT_GU; p += 8; }
    else { r -= 8 * IT_GU; job = 5; p = r / IT_DN; r -= p * IT_DN; p += 8; }
    ConvDesc d; d.K = D; d.N = D; d.ncols = D; d.col_off = 0; d.row_off = 0; d.map = 0; d.item = r; d.gain = nullptr; d.wmul = 1.0f; d.f8 = true;
    switch (job) {
    case 0: d.W = in[I_AWIN] + (size_t)p * D * AIN_N; d.N = AIN_N; d.gain = in[I_ANORM] + p * D;
            if (r < IT_AINQ) { d.ncols = 3 * D; d.WT = ws + W_AIN + p * W_AIN_SZ; d.wmul = IN_PRESCALE; d.map = 1; }
            else { d.ncols = AIN_N - 3 * D; d.WT = ws + W_AIN + p * W_AIN_SZ + W_AINX_OFF; d.map = 3; d.col_off = 3 * D; d.item = r - IT_AINQ; d.f8 = false; }
            break;
    case 1: d.W = in[I_AWOUT] + (size_t)p * D * D; d.WT = ws + W_AOUT + p * W_SQ_SZ; d.wmul = OUT_PRESCALE; break;
    case 2: d.W = in[I_DGU] + (size_t)p * D * 2 * DFF; d.N = 2 * DFF; d.ncols = 2 * DFF; d.WT = ws + W_DGU + p * W_GU8_SZ; d.gain = in[I_FFNNORM] + (2 * p) * D; d.wmul = GU_PRESCALE; d.map = 2; break;
    case 3: d.W = in[I_DDN] + (size_t)p * DFF * D; d.K = DFF; d.WT = ws + W_DDN + p * W_DN8_SZ; d.wmul = DN_PRESCALE; break;
    case 4: d.W = in[I_MGU] + (size_t)p * D * 2 * DFF; d.N = 2 * DFF; d.ncols = 2 * DFF; d.WT = ws + W_MGU + (size_t)p * W_GU8_SZ; d.gain = in[I_FFNNORM] + (2 * (p >> 3) + 1) * D; d.wmul = GU_PRESCALE; d.map = 2; break;
    case 5: d.W = in[I_MDN] + (size_t)p * DFF * D; d.K = DFF; d.WT = ws + W_MDN + (size_t)p * W_DN8_SZ; d.wmul = DN_PRESCALE; break;
    case 6: d.W = in[I_WKV]; d.N = 2 * D + NH; d.ncols = 2 * D; d.WT = ws + W_KVQ; d.gain = in[I_KVNORM]; d.wmul = IN_PRESCALE; d.row_off = D; break;
    case 7: d.W = in[I_WKV]; d.N = 2 * D + NH; d.ncols = NH; d.WT = ws + W_KVQ; d.gain = in[I_KVNORM]; d.wmul = IN_PRESCALE; d.row_off = 3 * D; d.col_off = 2 * D; break;
    case 8: d.W = in[I_BWQ]; d.WT = ws + W_KVQ; d.gain = in[I_BNORM]; d.wmul = IN_PRESCALE; break;
    case 9: d.W = in[I_BWQ] + (size_t)D * D; d.WT = ws + W_BQ3; d.gain = in[I_BNORM] + D; d.wmul = IN_PRESCALE; break;
    default: d.W = in[I_BWOUT] + (size_t)p * D * D; d.WT = ws + W_BOUT + p * W_SQ_SZ; d.wmul = OUT_PRESCALE; break;
    }
    return d;
}
__device__ __forceinline__ void conv_load(const ConvDesc& d, int lane, f32x4 (&v)[16]) {
    const int nblk = (d.ncols + 63) >> 6, kb = d.item / nblk, nb = d.item - kb * nblk, k0 = 64 * kb + 16 * (lane >> 4), n0 = 64 * nb + 4 * (lane & 15);
    const GAS f32x4* src = (const GAS f32x4*)(d.W + (size_t)k0 * d.N + d.col_off + n0); const int rs = d.N >> 2;
    if (n0 < d.ncols) {
#pragma unroll
        for (int i = 0; i < 16; ++i) v[i] = __builtin_nontemporal_load(src + (size_t)i * rs);
    }
}
__device__ __forceinline__ void conv_finish(const ConvDesc& d, int lane, f32x4 (&v)[16]) {
    const int nblk = (d.ncols + 63) >> 6, kb = d.item / nblk, nb = d.item - kb * nblk, k0 = 64 * kb + 16 * (lane >> 4), n0 = 64 * nb + 4 * (lane & 15);
    if (n0 >= d.ncols) return;
#pragma unroll
    for (int q = 0; q < 4; ++q) { f32x4 g = (f32x4){d.wmul, d.wmul, d.wmul, d.wmul}; if (d.gain) g = g * *(const GAS f32x4*)(d.gain + k0 + 4 * q);
#pragma unroll
        for (int c = 0; c < 4; ++c) v[4 * q + c] = v[4 * q + c] * g[c]; }
#pragma unroll
    for (int j = 0; j < 4; ++j) {
        const size_t drow = (size_t)(d.row_off + map_col(d.map, n0 + j));
        if (d.f8) { v4u o; o.x = pg8::pk4f8(v[0][j], v[1][j], v[2][j], v[3][j]); o.y = pg8::pk4f8(v[4][j], v[5][j], v[6][j], v[7][j]); o.z = pg8::pk4f8(v[8][j], v[9][j], v[10][j], v[11][j]); o.w = pg8::pk4f8(v[12][j], v[13][j], v[14][j], v[15][j]);
            *(GAS v4u*)(d.WT + drow * d.K + k0) = o; }
        else { GAS v4u* dst = (GAS v4u*)((bf16*)d.WT + drow * d.K + k0); v4u o0, o1;
            o0.x = pkbf(v[0][j], v[1][j]); o0.y = pkbf(v[2][j], v[3][j]); o0.z = pkbf(v[4][j], v[5][j]); o0.w = pkbf(v[6][j], v[7][j]);
            o1.x = pkbf(v[8][j], v[9][j]); o1.y = pkbf(v[10][j], v[11][j]); o1.z = pkbf(v[12][j], v[13][j]); o1.w = pkbf(v[14][j], v[15][j]);
            dst[0] = o0; dst[1] = o1; }
    }
}
__device__ __forceinline__ void conv_one(const KIn& in, unsigned char* ws, int r, int lane) { const ConvDesc d = conv_desc(in, ws, r); f32x4 v[16]; conv_load(d, lane, v); conv_finish(d, lane, v); }
__device__ __forceinline__ void p0_prologue(Frame& F, KArgs ap) {
    struct { KIn in; } A{{ap}};
    const int gw = F.vcu * NWAVES + F.wave, NGW = F.G * NWAVES;
    unsigned char* ws = F.ws;
    for (int it = gw; it < CV_SEG0; it += NGW) conv_one(A.in, ws, it, F.lane);
    {
        constexpr int ZA = AIN_NP - AIN_N, ZK = KVQ_NP - (3 * D + NH), ZROWS = 2 * ZA + ZK;
        for (int zr = gw; zr < ZROWS; zr += NGW) {
            if (zr < 2 * ZA) { bf16* dst = (bf16*)(ws + W_AIN + (zr / ZA) * W_AIN_SZ + W_AINX_OFF) + (size_t)(AIN_N - 3 * D + zr % ZA) * D; ((GAS v4u*)dst)[F.lane] = (v4u){0u, 0u, 0u, 0u}; ((GAS v4u*)dst)[64 + F.lane] = (v4u){0u, 0u, 0u, 0u}; }
            else { unsigned char* dst = ws + W_KVQ + (size_t)(3 * D + NH + (zr - 2 * ZA)) * D; ((GAS v4u*)dst)[F.lane] = (v4u){0u, 0u, 0u, 0u}; }
        }
    }
    {
        float* cosT = (float*)(ws + WS_COS); float* sinT = (float*)(ws + WS_SIN);
        for (int idx = (F.vcu * NWAVES + F.wave) * 64 + F.lane; idx < SEQ * 32; idx += F.G * NWAVES * 64) {
            const int t = idx >> 5, i = idx & 31;
            const float ang = (float)t * INVF_TAB[i];
            const double rev = (double)ang * 0.15915494309189535; const float fr = (float)(rev - floor(rev));
            cosT[idx] = __builtin_amdgcn_cosf(fr); sinT[idx] = __builtin_amdgcn_sinf(fr);
        }
    }
    {
        const float* x = A.in[I_X]; bf16* HB = (bf16*)(ws + WS_HB); unsigned char* HB8 = ws + WS_HB8; float* ssq = (float*)(ws + WS_SSQ);
        for (int m = gw; m < M; m += NGW) {
            const GAS f32x4* xr = (const GAS f32x4*)(x + (size_t)m * D) + F.lane; float s = 0.f;
            GAS unsigned long long* o8 = (GAS unsigned long long*)(HB + (size_t)m * D) + F.lane; GAS unsigned* o4 = (GAS unsigned*)(HB8 + (size_t)m * D) + F.lane;
#pragma unroll
            for (int j = 0; j < 4; ++j) { const f32x4 v = xr[64 * j]; s += (v.x * v.x + v.y * v.y) + (v.z * v.z + v.w * v.w);
                o8[64 * j] = (unsigned long long)pkbf(v.x, v.y) | ((unsigned long long)pkbf(v.z, v.w) << 32); o4[64 * j] = pg8::pk4f8(v.x, v.y, v.z, v.w); }
            s = wave_sum(s);
            if (F.lane < 16) ssq[(size_t)m * 16 + F.lane] = F.lane == 0 ? s : 0.f;
        }
    }
}

typedef float f32x16 __attribute__((ext_vector_type(16)));
__device__ __forceinline__ void sc_glds16(const void* gsrc, unsigned lds_dst) { unsigned keep;
    asm volatile("s_mov_b32 %0, m0\n\ts_mov_b32 m0, %2\n\ts_nop 0\n\tglobal_load_lds_dwordx4 %1, off\n\ts_mov_b32 m0, %0" : "=&s"(keep) : "v"(gsrc), "s"(lds_dst) : "memory"); }
__device__ __forceinline__ float relu_s(float x) { const int i = __float_as_int(x); return __int_as_float(i > 0 ? i : 0); }
struct ScUnit { int b, j, kc, nt; };
__device__ __forceinline__ ScUnit sc_full(int f) {
    ScUnit q; q.b = f / 960; int r = f % 960; int g = 1;
    while (r >= 8 * g) { r -= 8 * g; ++g; }
    q.j = 8 * g + r / g; q.kc = r % g; q.nt = 8; return q;
}
__device__ __forceinline__ ScUnit sc_natural(int u) {
    constexpr int UPB = 1088; ScUnit q; q.b = u / UPB; int r = u % UPB; int g = 0;
    while (r >= 8 * (g + 1)) { r -= 8 * (g + 1); ++g; }
    q.j = 8 * g + r / (g + 1); q.kc = r % (g + 1);
    const int s_beg = 512 * q.kc, s_end = (512 * (q.kc + 1) < 64 * (q.j + 1)) ? 512 * (q.kc + 1) : 64 * (q.j + 1); q.nt = (s_end - s_beg) >> 6; return q;
}
__device__ __forceinline__ bool sc_unit(int c, int G, int i, ScUnit& q) {
    if (G != 256) { const int u = c + i * G; if (u >= 2176) return false; q = sc_natural(u); return true; }
    if (i < 7) { q = sc_full(c + 256 * i); return true; }
    if (c < 128) { if (i > 7) return false; q = sc_full(1792 + c); return true; }
    if (i > 8) return false;
    const int cc = c - 128, cls = cc >> 5, idx = cc & 31, rem = (i == 7) ? 7 - cls : cls;
    q.b = idx >> 4; q.j = 8 * (idx & 15) + rem; q.kc = q.j >> 3; q.nt = rem + 1; return true;
}
__device__ __forceinline__ void idx_scores_phase(Frame& F, KArgs ap, int clo, int chi) {
    const KIn in{ap}; const int gw = F.vcu * NWAVES + F.wave, NGW = F.G * NWAVES;
    const bf16* QI = (const bf16*)(F.ws + WS_QI); const bf16* KI = (const bf16*)(F.ws + WS_KI); const float* WI = (const float*)(F.ws + WS_WI);
    _Float16* SC = (_Float16*)(F.ws + WS_SC);
    const int lane = F.lane, r32 = lane & 31, hi = lane >> 5, wave = F.wave;
    constexpr int KS_OFF = RING_OFF, TS_OFF = LDSCTL_OFF + 4096;
    const unsigned lds0 = (unsigned)(uintptr_t)(unsigned char*)F.lds;
    const LAS unsigned char* kfrag = F.lds + KS_OFF + hi * 1024 + r32 * 16;
    LAS _Float16* tsw = (LAS _Float16*)(F.lds + TS_OFF + wave * 2048) + hi * 64 + r32;
    const LAS v4u* tsr = (const LAS v4u*)(F.lds + TS_OFF + wave * 2048 + (lane >> 3) * 256 + (lane & 7) * 16);
#define SC_DMA(q, buf) do { const bf16* ks_ = KI + (size_t)((q).b * SEQ + 512 * (q).kc + lane) * 64 + wave * 8; \
        for (int t_ = 0; t_ < (q).nt; ++t_) sc_glds16(ks_ + (size_t)t_ * 64 * 64, (unsigned)__builtin_amdgcn_readfirstlane(lds0 + KS_OFF + (buf) * 65536 + t_ * 8192 + wave * 1024)); } while (0)
    int ui = 0, par = 0; ScUnit q, qn;
    bool have = sc_unit(F.vcu, F.G, 0, q);
    bf16x8 a[2][4]; f32x4 w[2][4];
#define SC_LOAD_AW(q) do { const int tk_ = (q).b * SEQ + 64 * (q).j + 8 * wave; \
        _Pragma("unroll") for (int rt = 0; rt < 2; ++rt) { \
            _Pragma("unroll") for (int ks = 0; ks < 4; ++ks) a[rt][ks] = *(const bf16x8*)(QI + (size_t)(tk_ + 4 * rt + (r32 >> 3)) * 512 + (r32 & 7) * 64 + ks * 16 + hi * 8); \
            _Pragma("unroll") for (int tl = 0; tl < 4; ++tl) w[rt][tl] = *(const f32x4*)(WI + (size_t)(tk_ + 4 * rt + tl) * 8 + 4 * hi); } } while (0)
    if (have) { SC_DMA(q, 0); SC_LOAD_AW(q); }
    asm volatile("s_waitcnt vmcnt(0)\n\ts_barrier" ::: "memory");
    while (have) {
        const bool hn = sc_unit(F.vcu, F.G, ui + 1, qn);
        const int tok0 = q.b * SEQ + 64 * q.j + 8 * wave;
        _Float16* dst = SC + (size_t)(tok0 + (lane >> 3)) * SEQ + 512 * q.kc + 8 * (lane & 7);
        const LAS unsigned char* kb = kfrag + par * 65536;
        const int cid = clo + gw + NGW * ui; f32x4 cv[16];
        if (cid < chi) conv_load(conv_desc(in, F.ws, cid), lane, cv);
        for (int it = 0; it < q.nt; ++it) {
#pragma unroll
            for (int ct = 0; ct < 2; ++ct) {
                bf16x8 bk[4];
#pragma unroll
                for (int ks = 0; ks < 4; ++ks) bk[ks] = *(const LAS bf16x8*)(kb + it * 8192 + ks * 2048 + ct * 512);
#pragma unroll
                for (int rt = 0; rt < 2; ++rt) {
                    f32x16 d = {};
#pragma unroll
                    for (int ks = 0; ks < 4; ++ks) d = __builtin_amdgcn_mfma_f32_32x32x16_bf16(a[rt][ks], bk[ks], d, 0, 0, 0);
#pragma unroll
                    for (int tl = 0; tl < 4; ++tl) { float p = 0.f;
#pragma unroll
                        for (int jj = 0; jj < 4; ++jj) p += w[rt][tl][jj] * relu_s(d[4 * tl + jj]);
                        tsw[(4 * rt + tl) * 128 + 32 * ct] = (_Float16)p; }
                }
            }
            typedef _Float16 h8 __attribute__((ext_vector_type(8)));
            const h8 va = __builtin_bit_cast(h8, tsr[0]), vb = __builtin_bit_cast(h8, tsr[8]);
            const v4u val = __builtin_bit_cast(v4u, (h8)(va + vb));
            if (!(F.dry & 1)) *(GAS v4u*)(dst + it * 64) = val;
            if (it == 0 && hn) SC_DMA(qn, par ^ 1);
        }
        if (cid < chi) conv_finish(conv_desc(in, F.ws, cid), lane, cv);
        if (hn) SC_LOAD_AW(qn);
        asm volatile("s_waitcnt vmcnt(0) lgkmcnt(0)\n\ts_barrier" ::: "memory");
        ++ui; par ^= 1; q = qn; have = hn;
    }
#undef SC_DMA
#undef SC_LOAD_AW
    for (; clo + gw + NGW * ui < chi; ++ui) conv_one(in, F.ws, clo + gw + NGW * ui, lane);
}

__device__ __forceinline__ unsigned wave_total(unsigned cnt, int nbits) {
    unsigned tot = 0;
    for (int b = 0; b < nbits; ++b) tot += (unsigned)__builtin_popcountll(__ballot((cnt >> b) & 1u)) << b;
    return tot;
}
template <int NPK> __device__ __forceinline__ unsigned count_ge(const unsigned (&pk)[NPK], unsigned cand) {
    unsigned cnt = 0; const unsigned addc = (0x8000u - cand) * 0x00010001u;
#pragma unroll
    for (int i = 0; i < NPK; ++i) cnt += (unsigned)__builtin_popcount((pk[i] + addc) & 0x80008000u);
    return wave_total(cnt, 8);
}
template <int NPK, int R> __device__ __forceinline__ void select_rows(const unsigned short* const (&sc)[R], int n, int lane, unsigned char* const (&mbase)[R]  ) {
    unsigned pk[R][NPK];
#pragma unroll
    for (int c = 0; c < NPK / 4; ++c)
#pragma unroll
        for (int r = 0; r < R; ++r) {
            v4u v = (v4u){0xFC00FC00u, 0xFC00FC00u, 0xFC00FC00u, 0xFC00FC00u};
            if (512 * c + 8 * lane < n) v = *(const GAS v4u*)(sc[r] + 512 * c + 8 * lane);
            pk[r][4 * c + 0] = v.x; pk[r][4 * c + 1] = v.y; pk[r][4 * c + 2] = v.z; pk[r][4 * c + 3] = v.w;
        }
    bool hipos[R];
#pragma unroll
    for (int r = 0; r < R; ++r) { unsigned cpos = 0;
#pragma unroll
        for (int i = 0; i < NPK; ++i) { const unsigned m = pk[r][i] & 0x7FFF7FFFu; cpos += (unsigned)__builtin_popcount((m + 0x7FFF7FFFu) & ~pk[r][i] & 0x80008000u); }
        hipos[r] = wave_total(cpos, 8) >= (unsigned)KSEL; }
#pragma unroll
    for (int r = 0; r < R; ++r)
#pragma unroll
        for (int c = 0; c < NPK / 4; ++c) { const bool valid = 512 * c + 8 * lane < n;
#pragma unroll
            for (int q = 0; q < 4; ++q) { const unsigned x = pk[r][4 * c + q], m = x & 0x7FFF7FFFu; const unsigned pos = ((m + 0x7FFF7FFFu) & ~x & 0x80008000u) >> 15, fill = pos * 0x7FFFu;
                const unsigned k = hipos[r] ? (m & fill) : ((0x7FFE7FFEu - m) | fill);
                pk[r][4 * c + q] = valid ? k : 0u; } }
    unsigned T[R];
#pragma unroll
    for (int r = 0; r < R; ++r) T[r] = 0;
    for (int bit = 14; bit >= 0; --bit) {
        unsigned cnt[R];
#pragma unroll
        for (int r = 0; r < R; ++r) { const unsigned addc = (0x8000u - (T[r] | (1u << bit))) * 0x00010001u; unsigned c = 0, c1 = 0, c2 = 0, c3 = 0;
#pragma unroll
            for (int i = 0; i < NPK; i += 4) { c += (unsigned)__builtin_popcount((pk[r][i] + addc) & 0x80008000u); c1 += (unsigned)__builtin_popcount((pk[r][i + 1] + addc) & 0x80008000u); c2 += (unsigned)__builtin_popcount((pk[r][i + 2] + addc) & 0x80008000u); c3 += (unsigned)__builtin_popcount((pk[r][i + 3] + addc) & 0x80008000u); }
            cnt[r] = (c + c1) + (c2 + c3); }
#pragma unroll
        for (int r = 0; r < R; ++r) if (wave_total(cnt[r], 8) >= (unsigned)KSEL) T[r] |= 1u << bit;
    }
#pragma unroll
    for (int r = 0; r < R; ++r) {
        const unsigned c_gt = count_ge<NPK>(pk[r], T[r] + 1u);
        const unsigned c_ge = count_ge<NPK>(pk[r], T[r]);
        const int need = KSEL - (int)c_gt;
        const bool all_ties = (int)(c_ge - c_gt) == need;
        const unsigned addg = (0x7FFFu - T[r]) * 0x00010001u, adde = (0x8000u - T[r]) * 0x00010001u;
        int base = 0;
#pragma unroll
        for (int c = 0; c < NPK / 4; ++c) {
            if (512 * c < n) {
                unsigned gtb = 0, geb = 0;
#pragma unroll
                for (int q = 0; q < 4; ++q) { const unsigned xg = pk[r][4 * c + q] + addg, xe = pk[r][4 * c + q] + adde;
                    gtb |= (((xg >> 15) & 1u) | ((xg >> 30) & 2u)) << (2 * q); geb |= (((xe >> 15) & 1u) | ((xe >> 30) & 2u)) << (2 * q); }
                const unsigned eqb = geb & ~gtb;
                unsigned sel = geb;
                if (!all_ties) {
                    const unsigned ceq = (unsigned)__builtin_popcount(eqb); unsigned pre = 0, tot = 0;
#pragma unroll
                    for (int b = 0; b < 4; ++b) { const unsigned long long bal = __ballot((ceq >> b) & 1u);
                        pre += __builtin_amdgcn_mbcnt_hi((unsigned)(bal >> 32), __builtin_amdgcn_mbcnt_lo((unsigned)bal, 0u)) << b; tot += (unsigned)__builtin_popcountll(bal) << b; }
                    int k = need - base - (int)pre; unsigned take = 0;
#pragma unroll
                    for (int jb = 0; jb < 8; ++jb) { const bool e = (eqb >> jb) & 1u; if (e && k > 0) { take |= 1u << jb; --k; } }
                    sel = gtb | take; base += (int)tot;
                }
                if (512 * c + 8 * lane < n) mbase[r][(size_t)(8 * c + (lane >> 3)) * SEQ * 8 + (lane & 7)] = (unsigned char)sel;
            }
        }
    }
}
__device__ __forceinline__ void idx_select_phase(Frame& F, KArgs ap, int clo, int chi) {
    const unsigned short* SC = (const unsigned short*)(F.ws + WS_SC); unsigned char* MK = F.ws + WS_MASK;
    const int gw = F.vcu * NWAVES + F.wave, NGW = F.G * NWAVES, lane = F.lane;
    const KIn in{ap};
    const int per = (chi - clo + NGW - 1) / NGW, nsel = (SEQ + NGW - 1) / NGW, quota = (per + nsel - 1) / nsel;
    bool conv_turn = F.wave >= NWAVES / 2;
    int t = gw, k = 0;
    while (t < SEQ || k < per) {
        if ((conv_turn || t >= SEQ) && k < per) {
            for (int e = 0; e < quota && k < per; ++e, ++k) { const int id = clo + gw + NGW * k; if (id < chi) conv_one(in, F.ws, id, lane); }
        } else if (t < SEQ) {
            const int n = 64 * (t / 64 + 1);
            unsigned char* const mb[2] = {MK + (size_t)t * 8, MK + ((size_t)(SEQ / 64) * SEQ + t) * 8};
            const unsigned short* const sc[2] = {SC + (size_t)t * SEQ, SC + (size_t)(SEQ + t) * SEQ};
            if (n <= KSEL) { if (8 * lane < n) { mb[0][(size_t)(lane >> 3) * SEQ * 8 + (lane & 7)] = 0xFF; mb[1][(size_t)(lane >> 3) * SEQ * 8 + (lane & 7)] = 0xFF; } }
            else if (n <= 1024) select_rows<8, 2>(sc, n, lane, mb);
            else if (n <= 2048) select_rows<16, 2>(sc, n, lane, mb);
            else if (n <= 4096) select_rows<32, 2>(sc, n, lane, mb);
            else { const unsigned short* const s0[1] = {sc[0]}; unsigned char* const m0[1] = {mb[0]}; select_rows<64, 1>(s0, n, lane, m0);
                   const unsigned short* const s1[1] = {sc[1]}; unsigned char* const m1[1] = {mb[1]}; select_rows<64, 1>(s1, n, lane, m1); }
            t += NGW;
        }
        conv_turn = !conv_turn;
    }
}

__device__ __forceinline__ void moe_router_phase(Frame& F, const bf16* h, const float* wr  , const float* gain, gu32* cnt) {
    LAS float* wl = (LAS float*)(F.lds + RING_OFF);
    LAS unsigned* lcnt = (LAS unsigned*)(F.lds + RING_OFF + 32768);
    LAS unsigned* rec = (LAS unsigned*)(F.lds + RING_OFF + 32768 + 64);
    for (int i = F.tid; i < 1024 * 8; i += NWAVES * 64) wl[i] = wr[i] * gain[i >> 3];
    if (F.tid < 16) lcnt[F.tid] = 0u;
    __syncthreads();
    unsigned* TOK = (unsigned*)(F.ws + WS_TOK);
    for (int blk = F.vcu; blk < M / 64; blk += F.G) {
        for (int q = 0; q < 8; ++q) {
            const int tl = F.wave * 8 + q, t = blk * 64 + tl;
            const GAS v2u* xr = (const GAS v2u*)(h + (size_t)t * D) + F.lane;
            float acc[8] = {0.f, 0.f, 0.f, 0.f, 0.f, 0.f, 0.f, 0.f}; float ss = 0.f;
#pragma unroll
            for (int j = 0; j < 4; ++j) { const v2u xw = xr[64 * j]; const f32x4 v = {__uint_as_float(xw.x << 16), __uint_as_float(xw.x & 0xFFFF0000u), __uint_as_float(xw.y << 16), __uint_as_float(xw.y & 0xFFFF0000u)}; ss += (v.x * v.x + v.y * v.y) + (v.z * v.z + v.w * v.w);
#pragma unroll
                for (int c = 0; c < 4; ++c) { const LAS f32x4* wp = (const LAS f32x4*)(wl + (size_t)(256 * j + 4 * F.lane + c) * 8); const f32x4 w0 = wp[0], w1 = wp[1]; const float xv = v[c];
                    acc[0] += xv * w0[0]; acc[1] += xv * w0[1]; acc[2] += xv * w0[2]; acc[3] += xv * w0[3]; acc[4] += xv * w1[0]; acc[5] += xv * w1[1]; acc[6] += xv * w1[2]; acc[7] += xv * w1[3]; } }
            ss = wave_sum(ss); const float rstd = 1.0f / sqrtf(ss * (1.0f / D) + pg8::RMS_EPS_F);
            float lg[8];
#pragma unroll
            for (int e = 0; e < 8; ++e) lg[e] = wave_sum(acc[e]) * rstd;
            int e1 = 0; float l1 = lg[0];
#pragma unroll
            for (int e = 1; e < 8; ++e) if (lg[e] > l1) { l1 = lg[e]; e1 = e; }
            int e2 = -1; float l2 = -INFINITY;
#pragma unroll
            for (int e = 0; e < 8; ++e) if (e != e1 && lg[e] > l2) { l2 = lg[e]; e2 = e; }
            const float g1 = 1.0f / (1.0f + __expf(l2 - l1)), g2 = 1.0f - g1;
            if (F.lane == 0) { const unsigned s1 = atomicAdd((unsigned*)&lcnt[e1], 1u), s2 = atomicAdd((unsigned*)&lcnt[e2], 1u);
                LAS unsigned* rc = rec + tl * 8; rc[0] = (unsigned)e1; rc[1] = (unsigned)e2; rc[2] = s1; rc[3] = s2; rc[4] = __float_as_uint(g1); rc[5] = __float_as_uint(g2); rc[6] = __float_as_uint(rstd); rc[7] = 0u; }
        }
        __syncthreads();
        if (F.tid < 8) lcnt[8 + F.tid] = __hip_atomic_fetch_add(cnt + F.tid, lcnt[F.tid], __ATOMIC_RELAXED, __HIP_MEMORY_SCOPE_AGENT);
        __syncthreads();
        if (F.tid < 64) { const LAS unsigned* rc = rec + F.tid * 8; unsigned* o = TOK + (size_t)(blk * 64 + F.tid) * 8;
            const unsigned e1 = rc[0], e2 = rc[1];
            v4u a; a.x = e1; a.y = e2; a.z = rc[2] + lcnt[8 + e1]; a.w = rc[3] + lcnt[8 + e2]; v4u bq; bq.x = rc[4]; bq.y = rc[5]; bq.z = rc[6]; bq.w = 0u;
            *(v4u*)o = a; *(v4u*)(o + 4) = bq; }
        __syncthreads();
        if (F.tid < 16) lcnt[F.tid] = 0u;
        __syncthreads();
    }
}
__device__ __forceinline__ void moe_gather_phase(Frame& F, const gu32* cnt) {
    int rb[8]; { int acc = 0;
#pragma unroll
        for (int e = 0; e < 8; ++e) { rb[e] = acc * 256; acc += (int)((__builtin_amdgcn_readfirstlane(__hip_atomic_load(cnt + e, RLX_AGENT)) + 255u) >> 8); } }
    unsigned* TOK = (unsigned*)(F.ws + WS_TOK); const unsigned char* HB8 = F.ws + WS_HB8; unsigned char* AS = F.ws + WS_ASORT;
    float* RSD = (float*)(F.ws + WS_RSD); float* GATE = (float*)(F.ws + WS_GATE);
    const int gw = F.vcu * NWAVES + F.wave, NGW = F.G * NWAVES;
    for (int t0 = gw; t0 < M; t0 += 4 * NGW) {
        v4u a[4], bq[4], v0[4];
#pragma unroll
        for (int q = 0; q < 4; ++q) { const int t = t0 + q * NGW; a[q] = *(const v4u*)(TOK + (size_t)t * 8); bq[q] = *(const v4u*)(TOK + (size_t)t * 8 + 4); v0[q] = ((const GAS v4u*)(HB8 + (size_t)t * D))[F.lane]; }
#pragma unroll
        for (int q = 0; q < 4; ++q) { const int t = t0 + q * NGW;
            int r1 = (int)a[q].z, r2 = (int)a[q].w;
#pragma unroll
            for (int e = 0; e < 8; ++e) { r1 += ((int)a[q].x == e) ? rb[e] : 0; r2 += ((int)a[q].y == e) ? rb[e] : 0; }
            ((GAS v4u*)(AS + (size_t)r1 * D))[F.lane] = v0[q]; ((GAS v4u*)(AS + (size_t)r2 * D))[F.lane] = v0[q];
            if (F.lane == 0) { RSD[r1] = __uint_as_float(bq[q].z); RSD[r2] = __uint_as_float(bq[q].z); GATE[r1] = __uint_as_float(bq[q].x); GATE[r2] = __uint_as_float(bq[q].y);
                v2u rr; rr.x = (unsigned)r1; rr.y = (unsigned)r2; *(v2u*)(TOK + (size_t)t * 8 + 2) = rr; } }
    }
}
template <bool FINAL> __device__ __forceinline__ void moe_combine_phase(Frame& F, const bf16* hin, float* out_f32, bf16* hs, const float* fgain) {
    const unsigned* TOK = (const unsigned*)(F.ws + WS_TOK); const bf16* Y = (const bf16*)(F.ws + WS_Y); unsigned char* HB8 = F.ws + WS_HB8; float* ssq = (float*)(F.ws + WS_SSQ);
    const int gw = F.vcu * NWAVES + F.wave, NGW = F.G * NWAVES;
    for (int t0 = gw; t0 < M; t0 += 2 * NGW) {
        v2u rr[2]; v2u hw[2][4], ya[2][4], yb[2][4];
#pragma unroll
        for (int q = 0; q < 2; ++q) rr[q] = *(const v2u*)(TOK + (size_t)(t0 + q * NGW) * 8 + 2);
#pragma unroll
        for (int q = 0; q < 2; ++q) { const int t = t0 + q * NGW; const GAS v2u* hi_ = (const GAS v2u*)(hin + (size_t)t * D) + F.lane;
            const GAS v2u* y1 = (const GAS v2u*)(Y + (size_t)rr[q].x * D) + F.lane; const GAS v2u* y2 = (const GAS v2u*)(Y + (size_t)rr[q].y * D) + F.lane;
#pragma unroll
            for (int j = 0; j < 4; ++j) { hw[q][j] = hi_[64 * j]; ya[q][j] = y1[64 * j]; yb[q][j] = y2[64 * j]; } }
#pragma unroll
        for (int q = 0; q < 2; ++q) { const int t = t0 + q * NGW; float s = 0.f; f32x4 v[4];
#pragma unroll
            for (int j = 0; j < 4; ++j) { const v2u a = ya[q][j], bq = yb[q][j], hh = hw[q][j]; f32x4& w = v[j];
                w.x = __uint_as_float(hh.x << 16) + (__uint_as_float(a.x << 16) + __uint_as_float(bq.x << 16)); w.y = __uint_as_float(hh.x & 0xFFFF0000u) + (__uint_as_float(a.x & 0xFFFF0000u) + __uint_as_float(bq.x & 0xFFFF0000u));
                w.z = __uint_as_float(hh.y << 16) + (__uint_as_float(a.y << 16) + __uint_as_float(bq.y << 16)); w.w = __uint_as_float(hh.y & 0xFFFF0000u) + (__uint_as_float(a.y & 0xFFFF0000u) + __uint_as_float(bq.y & 0xFFFF0000u));
                s += (w.x * w.x + w.y * w.y) + (w.z * w.z + w.w * w.w); }
            s = wave_sum(s);
            if (FINAL) { const float rstd = 1.0f / sqrtf(s * (1.0f / D) + pg8::RMS_EPS_F); GAS f32x4* hr = (GAS f32x4*)(out_f32 + (size_t)t * D) + F.lane;
#pragma unroll
                for (int j = 0; j < 4; ++j) { const f32x4 g = ((const GAS f32x4*)fgain)[64 * j + F.lane]; hr[64 * j] = v[j] * rstd * g; } }
            else { GAS unsigned* o4 = (GAS unsigned*)(HB8 + (size_t)t * D) + F.lane; GAS v2u* o8 = (GAS v2u*)(hs + (size_t)t * D) + F.lane;
#pragma unroll
                for (int j = 0; j < 4; ++j) { v2u w; w.x = pkbf(v[j].x, v[j].y); w.y = pkbf(v[j].z, v[j].w); o8[64 * j] = w; o4[64 * j] = pg8::pk4f8(v[j].x, v[j].y, v[j].z, v[j].w); }
                if (F.lane < 16) ssq[(size_t)t * 16 + F.lane] = F.lane == 0 ? s : 0.f; } }
    }
}
__device__ __forceinline__ void fox_scan_phase(Frame& F) {
    const float* LOGF = (const float*)(F.ws + WS_LOGF); float* GK = (float*)(F.ws + WS_GK);
    LAS float* part = (LAS float*)(F.lds + RING_OFF);
    for (int bh = F.vcu; bh < BATCH * NH; bh += F.G) {
        const int b = bh / NH, hh = bh % NH; float v[16]; float run = 0.f;
#pragma unroll
        for (int k = 0; k < 16; ++k) { run += LOGF[(size_t)(b * SEQ + F.tid * 16 + k) * 16 + hh]; v[k] = run; }
        float incl = run;
#pragma unroll
        for (int o = 1; o < 64; o <<= 1) { const float up = __shfl_up(incl, o); if (F.lane >= o) incl += up; }
        if (F.lane == 63) part[F.wave] = incl;
        __syncthreads();
        float off = incl - run;
        for (int w = 0; w < F.wave; ++w) off += part[w];
#pragma unroll
        for (int k = 0; k < 16; ++k) GK[(size_t)bh * SEQ + F.tid * 16 + k] = -(off + v[k]) * LOG2E;
        __syncthreads();
    }
}

__device__ __forceinline__ Frame make_frame(unsigned char* lds_generic, KArgs ap, const int wv) {
    Frame F; F.lds = (LAS unsigned char*)lds_generic; F.MISC = (volatile LAS unsigned*)(F.lds + MISC_OFF);
    F.lane = lane_id_v(); F.wave = wv; F.tid = wv * 64 + F.lane;
    F.G = gridDim.x; { const int bx = blockIdx.x; F.vcu = (F.G % 8 == 0) ? (bx % 8) * (F.G / 8) + bx / 8 : bx; }
    F.ws = (unsigned char*)ap->ws; F.ctl = (gu32*)(F.ws + WS_CTL); F.dry = ap->pad;
    return F;
}
__device__ __forceinline__ void phase_barrier(unsigned char* lds_generic, KArgs ap, const int wv) {
    XcdBarrier bar; bar.bar = (unsigned*)((unsigned char*)ap->ws + WS_CTL) + CW_BAR + ap->li * XCD_BAR_WORDS; bar.x = xb_xcc_id(); bar.st = (volatile LAS unsigned*)((LAS unsigned char*)lds_generic + MISC_OFF) + 8;
    xcd_barrier(bar, wv == 0 && lane_id_v() == 0);
}
#ifndef MK_PROBE
#define MK_PROBE 0
#endif
#ifndef PA0
#define PA0 0
#define PA1 32
#define PB0 0
#define PB1 1
#define PB_SCALE 20.0f
#endif
#if MK_PROBE
#define STAMP(k) do { if (blockIdx.x == 0 && wv == 0 && lane_id_v() == 0) ((volatile LAS unsigned*)(size_t)(LDSCTL_OFF + 1024))[k] = (unsigned)__builtin_amdgcn_s_memrealtime(); } while (0)
#else
#define STAMP(k) do {} while (0)
#endif
#define PHASE_BEGIN(k) if (ap->ph_lo <= (k) && (k) < ap->ph_hi) { STAMP(k); Frame F = make_frame(lds_generic, ap, wv);
#define PHASE_END(k)   if (MK_ONE_LAUNCH && (k) + 1 < ap->ph_hi) phase_barrier(lds_generic, ap, wv); }
template <int L> __device__ __forceinline__ void layer(KArgs ap, unsigned char* lds_generic, const int wv) {
    constexpr int P = (L == 0) ? 1 : (L == 1) ? 8 : (L == 2) ? 18 : 24;
#define ws (F.ws)
#define hout ((float*)ap->out)
#define HB ((bf16*)(ws + WS_HB))
#define SSQ ((float*)(ws + WS_SSQ))
#define Qb ((bf16*)(ws + WS_Q))
#define Kb ((bf16*)(ws + WS_K))
#define Vb ((bf16*)(ws + WS_V))
#define Ob ((bf16*)(ws + WS_O))
#define H2 ((bf16*)(ws + WS_H2))
#define cosT ((const float*)(ws + WS_COS))
#define sinT ((const float*)(ws + WS_SIN))
    constexpr int PO = (L < 2) ? P + 4 : (L == 2 ? P + 3 : P + 2);
    if constexpr (L < 2) {
        PHASE_BEGIN(P) {
            { pg8::Gemm g{(const bf16*)(ws + WS_HB8), (const bf16*)(ws + W_AIN + L * W_AIN_SZ), M, 3 * D, D / 2}; pg8::StaticOrder S; S.init(M, 3 * D, F.G, (int)blockIdx.x);
              pg8::EpiAin E{Qb, Kb, Vb, (bf16*)(ws + WS_QI), (bf16*)(ws + WS_KI), (float*)(ws + WS_WI), SSQ, cosT, sinT, C2, 1.0f / IN_PRESCALE, 0};
              pg8::gemm_phase<pg8::EpiAin, pg8::StaticOrder, true, true, 1>(F.lds + RING_OFF, g, S, E, wv); }
            { pg8::Gemm g{HB, (const bf16*)(ws + W_AIN + L * W_AIN_SZ + W_AINX_OFF), M, AIN_NP - 3 * D, D}; pg8::StaticOrder S; S.init(M, AIN_NP - 3 * D, F.G, (int)blockIdx.x);
              pg8::EpiAin E{Qb, Kb, Vb, (bf16*)(ws + WS_QI), (bf16*)(ws + WS_KI), (float*)(ws + WS_WI), SSQ, cosT, sinT, C2, 1.0f, 12};
              pg8::gemm_phase<pg8::EpiAin, pg8::StaticOrder, true, true, 0>(F.lds + RING_OFF, g, S, E, wv); }
        } PHASE_END(P)
        PHASE_BEGIN(P + 1) idx_scores_phase(F, ap, L == 0 ? CV_SEG0 : CV_SEG1, L == 0 ? CV_MID0 : CV_MID1); PHASE_END(P + 1)
        PHASE_BEGIN(P + 2) idx_select_phase(F, ap, L == 0 ? CV_MID0 : CV_MID1, L == 0 ? CV_SEG1 : CV_SEG2); PHASE_END(P + 2)
        PHASE_BEGIN(P + 3) {
            const attn_body::AttnTensors AT{(const attn_body::bf16*)Qb, (const attn_body::bf16*)Kb, (const attn_body::bf16*)Vb, (attn_body::bf16*)Ob, nullptr, (const unsigned long long*)(ws + WS_MASK)};
            const attn_body::StaticOrder S((int)F.G, (int)blockIdx.x);
            attn_body::attn_phase<1, attn_body::StaticOrder>((char*)lds_generic + RING_OFF, AT, S, wv);
        } PHASE_END(P + 3)
    } else {
        PHASE_BEGIN(P) {
            constexpr int NP = (L == 2) ? KVQ_NP : D;
            pg8::Gemm g{(const bf16*)(ws + WS_HB8), (const bf16*)(ws + (L == 2 ? W_KVQ : W_BQ3)), M, NP, D / 2}; pg8::StaticOrder S; S.init(M, NP, F.G, (int)blockIdx.x);
            pg8::EpiKVQ E{Qb, (size_t)(WS_K - WS_Q) / 2, (float*)(ws + WS_LOGF), (const float*)ap->in[I_BF], SSQ, C2, 1.0f / IN_PRESCALE};
            pg8::gemm_phase<pg8::EpiKVQ, pg8::StaticOrder, true, true, 1>(F.lds + RING_OFF, g, S, E, wv);
        } PHASE_END(P)
        if constexpr (L == 2) { PHASE_BEGIN(P + 1) fox_scan_phase(F); PHASE_END(P + 1) }
        PHASE_BEGIN(PO - 1) {
            const attn_body::AttnTensors AT{(const attn_body::bf16*)Qb, (const attn_body::bf16*)Kb, (const attn_body::bf16*)Vb, (attn_body::bf16*)Ob, (const float*)(ws + WS_GK), nullptr};
            attn_body::attn_phase_queue<0>((char*)lds_generic + RING_OFF, AT, (unsigned*)(F.ctl + CW_AQ + 64 * (L - 2) + 16 * ap->li), (volatile LAS unsigned*)(F.lds + LDSCTL_OFF + 3072), wv, F.tid == 0);
        } PHASE_END(PO - 1)
    }
    PHASE_BEGIN(PO) {
        const bf16* Wo = (const bf16*)(ws + (L < 2 ? W_AOUT + L * W_SQ_SZ : W_BOUT + (L - 2) * W_SQ_SZ));
        pg8::Gemm g{Ob, Wo, M, D, D / 2}; pg8::StaticOrder S; S.init(M, D, F.G, (int)blockIdx.x);
        pg8::EpiRes<L == 0> E{(L == 0) ? (const void*)ap->in[I_X] : (const void*)HB, H2, ws + WS_HB8, SSQ, 1.0f / OUT_PRESCALE};
        pg8::gemm_phase<pg8::EpiRes<L == 0>, pg8::StaticOrder, true, true, 1>(F.lds + RING_OFF, g, S, E, wv);
    } PHASE_END(PO)
    if constexpr ((L & 1) == 0) {
        PHASE_BEGIN(PO + 1) {
            pg8::Gemm g{(const bf16*)(ws + WS_HB8), (const bf16*)(ws + W_DGU + (L >> 1) * W_GU8_SZ), M, 2 * DFF, D / 2}; pg8::StaticOrder S; S.init(M, 2 * DFF, F.G, (int)blockIdx.x);
            pg8::EpiSwiglu E{ws + WS_ACT, SSQ, nullptr, 2 * DFF / 256, 1.0f / GU_PRESCALE, F.dry};
            pg8::gemm_phase<pg8::EpiSwiglu, pg8::StaticOrder, true, true, 1>(F.lds + RING_OFF, g, S, E, wv);
        } PHASE_END(PO + 1)
        PHASE_BEGIN(PO + 2) {
            pg8::Gemm g{(const bf16*)(ws + WS_ACT), (const bf16*)(ws + W_DDN + (L >> 1) * W_DN8_SZ), M, D, DFF / 2}; pg8::StaticOrder S; S.init(M, D, F.G, (int)blockIdx.x);
            pg8::EpiRes<false> E{(const void*)H2, HB, ws + WS_HB8, SSQ, 1.0f / DN_PRESCALE};
            pg8::gemm_phase<pg8::EpiRes<false>, pg8::StaticOrder, true, true, 1>(F.lds + RING_OFF, g, S, E, wv);
        } PHASE_END(PO + 2)
    } else {
#define cnt (F.ctl + CW_CNT + 64 * (L >> 1))
        PHASE_BEGIN(PO + 1) moe_router_phase(F, H2, (const float*)ap->in[I_ROUTER] + (size_t)(L >> 1) * D * NEXP, (const float*)ap->in[I_FFNNORM] + L * D, cnt); PHASE_END(PO + 1)
        PHASE_BEGIN(PO + 2) moe_gather_phase(F, cnt); PHASE_END(PO + 2)
        PHASE_BEGIN(PO + 3) {
            pg8::Gemm g{(const bf16*)(ws + WS_ASORT), (const bf16*)(ws + W_MGU + (size_t)(L >> 1) * 8 * W_GU8_SZ), SORT_ROWS, 2 * DFF, D / 2};
            pg8::GroupedOrder S; S.init((const unsigned*)cnt, 2 * DFF / 256, F.G, (int)blockIdx.x, (LAS int*)(F.lds + LDSCTL_OFF + 2048), F.tid == 0);
            pg8::EpiSwiglu E{ws + WS_ACT, nullptr, (const float*)(ws + WS_RSD), 2 * DFF / 256, 1.0f / GU_PRESCALE, F.dry};
            pg8::gemm_phase<pg8::EpiSwiglu, pg8::GroupedOrder, true, true, 1>(F.lds + RING_OFF, g, S, E, wv);
        } PHASE_END(PO + 3)
        PHASE_BEGIN(PO + 4) {
            pg8::Gemm g{(const bf16*)(ws + WS_ACT), (const bf16*)(ws + W_MDN + (size_t)(L >> 1) * 8 * W_DN8_SZ), SORT_ROWS, D, DFF / 2};
            pg8::GroupedOrder S; S.init((const unsigned*)cnt, D / 256, F.G, (int)blockIdx.x, (LAS int*)(F.lds + LDSCTL_OFF + 2048), F.tid == 0);
            pg8::EpiMoeDown E{(bf16*)(ws + WS_Y), (const float*)(ws + WS_GATE), 1.0f / DN_PRESCALE};
            pg8::gemm_phase<pg8::EpiMoeDown, pg8::GroupedOrder, true, true, 1>(F.lds + RING_OFF, g, S, E, wv);
        } PHASE_END(PO + 4)
        PHASE_BEGIN(PO + 5) { if constexpr (L == 3) moe_combine_phase<true>(F, H2, hout, nullptr, (const float*)ap->in[I_FNORM]); else moe_combine_phase<false>(F, H2, nullptr, HB, nullptr); } PHASE_END(PO + 5)
    }
#undef ws
#undef hout
#undef HB
#undef SSQ
#undef Qb
#undef Kb
#undef Vb
#undef Ob
#undef H2
#undef cosT
#undef sinT
#undef cnt
}
__global__ void __launch_bounds__(NWAVES * 64, 2) yoco_fwd(Args args_unused) {
    extern __shared__ __attribute__((aligned(16))) unsigned char lds[];
    KArgs ap = (KArgs)__builtin_amdgcn_kernarg_segment_ptr();
    unsigned char* lds_generic = lds;
    const int wv = __builtin_amdgcn_readfirstlane(threadIdx.x >> 6);
    {
        LAS unsigned char* l3 = (LAS unsigned char*)lds;
        for (int u = threadIdx.x; u < (LDS_BYTES - LDSCTL_OFF) / 4; u += NWAVES * 64) ((LAS unsigned*)(l3 + LDSCTL_OFF))[u] = 0u;
        __syncthreads();
        if (MK_ONE_LAUNCH) (void)xcd_barrier_post((unsigned*)((unsigned char*)ap->ws + WS_CTL) + CW_BAR + ap->li * XCD_BAR_WORDS, (volatile LAS unsigned*)(l3 + MISC_OFF) + 8, threadIdx.x == 0);
    }
    PHASE_BEGIN(0) p0_prologue(F, ap); PHASE_END(0)
    layer<0>(ap, lds_generic, wv);
#if defined(MK_EXTRA_BAR)
    for (int xb_ = 0; xb_ < MK_EXTRA_BAR; ++xb_) phase_barrier(lds_generic, ap, wv);
#endif
    layer<1>(ap, lds_generic, wv);
    layer<2>(ap, lds_generic, wv);
    layer<3>(ap, lds_generic, wv);
#if MK_PROBE
    phase_barrier(lds_generic, ap, wv); STAMP(32);
    if (blockIdx.x == 0) {
        __syncthreads();
        volatile LAS unsigned* st = (volatile LAS unsigned*)(size_t)(LDSCTL_OFF + 1024);
        float a_us = (float)(st[PA1] - st[PA0]) * 0.01f, b_val = (float)(st[PB1] - st[PB0]) * 0.01f; a_us = __builtin_amdgcn_exp2f(__builtin_rintf(__builtin_amdgcn_logf(a_us) * 6.0f) * (1.0f / 6.0f)); b_val = __builtin_amdgcn_exp2f(__builtin_rintf(__builtin_amdgcn_logf(b_val) * 6.0f) * (1.0f / 6.0f)) / PB_SCALE;
        float* o = (float*)ap->out;
        for (int i = wv * 64 + lane_id_v(); i < 1024 * 1024; i += NWAVES * 64) o[1024 + i] = b_val;
        if (wv == 0 && lane_id_v() == 0) o[0] = a_us;
    }
#endif
}
#undef PHASE_BEGIN
#undef PHASE_END
constexpr int N_PHASES = 1 + (4 + 1 + 2) + (4 + 1 + 5) + (3 + 1 + 2) + (2 + 1 + 5);

extern "C" void kernel_launch(void* const* d_in, const int* in_sizes, int n_in, void* d_out, int out_size, void* d_ws, size_t ws_size, hipStream_t stream) {
    static int grid = 0;
    if (grid == 0) {
        if (n_in != 17 || in_sizes[0] != M * D || out_size != M * D || ws_size < WS_END) { fprintf(stderr, "kernel_launch: unexpected shapes (n_in %d, in0 %d, out %d, ws %zu < %zu); nothing launched\n", n_in, n_in > 0 ? in_sizes[0] : -1, out_size, ws_size, (size_t)WS_END); grid = -1; return; }
        int dev = 0, cus = 0, per_cu = 0;
        if (hipGetDevice(&dev) != hipSuccess || hipDeviceGetAttribute(&cus, hipDeviceAttributeMultiprocessorCount, dev) != hipSuccess) { grid = -1; return; }
        if (hipFuncSetAttribute((const void*)yoco_fwd, hipFuncAttributeMaxDynamicSharedMemorySize, LDS_BYTES) != hipSuccess) { fprintf(stderr, "kernel_launch: hipFuncSetAttribute failed\n"); grid = -1; return; }
        if (hipOccupancyMaxActiveBlocksPerMultiprocessor(&per_cu, (const void*)yoco_fwd, NWAVES * 64, LDS_BYTES) != hipSuccess || per_cu < 1) { fprintf(stderr, "kernel_launch: occupancy query reports %d workgroups per CU\n", per_cu); }
        (void)hipGetLastError();
        grid = cus;
    }
    if (grid < 0) return;
    if (hipMemsetAsync((char*)d_ws + WS_CTL, 0, CTL_ZERO_BYTES, stream) != hipSuccess) return;
    Args a{};
    for (int i = 0; i < 17; ++i) a.in[i] = (const float*)d_in[i];
    a.out = (float*)d_out; a.ws = (unsigned char*)d_ws;
#if defined(MK_RERUN_LO)
#ifndef MK_RERUN_DRY
#define MK_RERUN_DRY 0
#endif
#ifndef MK_RERUN_REP
#define MK_RERUN_REP 1
#endif
    { const int cuts[4][2] = {{0, MK_RERUN_HI}, {MK_RERUN_LO, MK_RERUN_HI}, {MK_RERUN_HI, N_PHASES}, {0, 0}};
      for (int li = 0; li < 3; ++li) { if (cuts[li][0] >= cuts[li][1]) continue; a.ph_lo = cuts[li][0]; a.ph_hi = cuts[li][1]; a.li = li; a.pad = (li == 1) ? MK_RERUN_DRY : 0; for (int rep = 0; rep < ((li == 1) ? MK_RERUN_REP : 1); ++rep) hipLaunchKernelGGL(yoco_fwd, dim3(grid), dim3(NWAVES * 64), LDS_BYTES, stream, a); } }
#elif MK_ONE_LAUNCH
    a.ph_lo = 0; a.ph_hi = N_PHASES;
    hipLaunchKernelGGL(yoco_fwd, dim3(grid), dim3(NWAVES * 64), LDS_BYTES, stream, a);
#else
    for (int p = 0; p < N_PHASES; ++p) { a.ph_lo = p; a.ph_hi = p + 1; hipLaunchKernelGGL(yoco_fwd, dim3(grid), dim3(NWAVES * 64), LDS_BYTES, stream, a); }
#endif
}
```

```cpp
#include <hip/hip_runtime.h>
#include <cstdio>
#include <cstdint>
namespace pg8 {
#define PG8_LAS __attribute__((address_space(3)))
typedef unsigned short bf16_t;
typedef short bf16x8 __attribute__((ext_vector_type(8)));
typedef float f32x4 __attribute__((ext_vector_type(4)));
typedef unsigned u32x4 __attribute__((ext_vector_type(4)));
typedef int i32x4 __attribute__((ext_vector_type(4)));
typedef int i32x8 __attribute__((ext_vector_type(8)));
constexpr int BM = 256, BK = 64, HALF = 128, HTB = HALF * BK * 2  , STAGE_BYTES = 8 * HTB, NXCD = 8, WGM = 8;

__host__ __device__ __forceinline__ int lds_byte(int r, int c) { const int st = (r >> 4) * 2 + (c >> 5), rr = r & 15, cc = c & 31, ob = rr * 64 + cc * 2; return st * 1024 + (ob ^ (((ob >> 9) & 1) << 5)); }
__host__ __device__ __forceinline__ void stage_rc(int b, int& R, int& C) { const int st = b / 1024, sb = b % 1024, swz = sb ^ (((sb >> 9) & 1) << 5); R = (st >> 1) * 16 + swz / 64; C = (st & 1) * 32 + (swz % 64) / 2; }
__host__ __device__ __forceinline__ int perm32(int rho) { const int n = rho >> 4, i = rho & 15; return 8 * (i >> 2) + 4 * n + (i & 3); }

struct Unit { int pm, pn; };
struct Gemm { const bf16_t* A; const bf16_t* Bt; int M, N, K; };

struct StaticOrder {
    int nM, nN, nwg, G, c;
    __host__ __device__ void init(int M, int N, int G_, int c_) { nM = M / BM; nN = N / BM; nwg = nM * nN; G = G_; c = c_; }
    __host__ __device__ bool next(int i, Unit& u) const {
        const long L = (long)i * G + c; if (L >= nwg) return false;
        int wgid = (int)L; { const int q = nwg / NXCD, r = nwg % NXCD, xcd = wgid % NXCD, off = wgid / NXCD; wgid = (xcd < r ? xcd * (q + 1) : r * (q + 1) + (xcd - r) * q) + off; }
        const int nig = WGM * nN, gid = wgid / nig, fm = gid * WGM, gsz = (nM - fm) < WGM ? (nM - fm) : WGM;
        u.pm = fm + ((wgid % nig) % gsz); u.pn = (wgid % nig) / gsz; return true;
    }
    __device__ __forceinline__ void a_ready(const Unit&) const {}
    __device__ __forceinline__ void done(const Unit&) const {}
};

typedef float f32x2 __attribute__((ext_vector_type(2)));
typedef unsigned u32x2 __attribute__((ext_vector_type(2)));
__device__ __forceinline__ unsigned pkbf(float lo, float hi) { typedef __bf16 b2 __attribute__((ext_vector_type(2))); f32x2 v = {lo, hi}; b2 b = __builtin_convertvector(v, b2); return __builtin_bit_cast(unsigned, b); }
__device__ __forceinline__ unsigned pk4f8(float a, float b, float c, float d) { int w = 0; w = __builtin_amdgcn_cvt_pk_fp8_f32(a, b, w, false); w = __builtin_amdgcn_cvt_pk_fp8_f32(c, d, w, true); return (unsigned)w; }
constexpr float RMS_EPS_F = 1e-6f;
constexpr int DMODEL = 1024, SSQ_PARTS = 16;
__device__ __forceinline__ float xsum_rows(float s) {
    const auto a = __builtin_amdgcn_permlane32_swap(__float_as_uint(s), __float_as_uint(s), false, false); s = __uint_as_float(a[0]) + __uint_as_float(a[1]);
    const auto b = __builtin_amdgcn_permlane16_swap(__float_as_uint(s), __float_as_uint(s), false, false); return __uint_as_float(b[0]) + __uint_as_float(b[1]);
}
__device__ __forceinline__ void rstd_rows(const float* ssq, int row0, int fq, float (&rs)[2][4]) {
#pragma unroll
    for (int ai = 0; ai < 2; ++ai)
#pragma unroll
        for (int m = 0; m < 4; ++m) { const f32x4 p = *(const f32x4*)(ssq + (size_t)(row0 + ai * HALF + m * 16) * SSQ_PARTS + 4 * fq);
            float s = (p[0] + p[1]) + (p[2] + p[3]); s = xsum_rows(s);
            rs[ai][m] = 1.0f / sqrtf(s * (1.0f / DMODEL) + RMS_EPS_F); }
}
__device__ __forceinline__ void rstd_half(const float* ssq, int row0, int fq, float sc, float (&rs)[4]) {
#pragma unroll
    for (int m = 0; m < 4; ++m) { const f32x4 p = *(const f32x4*)(ssq + (size_t)(row0 + m * 16) * SSQ_PARTS + 4 * fq);
        float s = (p[0] + p[1]) + (p[2] + p[3]); s = xsum_rows(s); rs[m] = sc / sqrtf(s * (1.0f / DMODEL) + RMS_EPS_F); }
}
template <bool BASEF32> struct EpiRes {
    static constexpr bool PERM = true, AFTER_DRAIN = false;
    const void* base; bf16_t* out; unsigned char* hb8; float* ssq; float ascale;
    __device__ __forceinline__ void operator()(const f32x4 (&acc)[2][2][4][2], const Unit& u, int wr, int wc, int fr, int fq) const {
        const int row0 = u.pm * BM + wr * 64 + fr, col0 = u.pn * BM + wc * 32 + 8 * fq;
#pragma unroll
        for (int ai = 0; ai < 2; ++ai)
#pragma unroll
            for (int m = 0; m < 4; ++m) { const int row = row0 + ai * HALF + m * 16; float sq = 0.f;
#pragma unroll
                for (int bj = 0; bj < 2; ++bj) { const size_t off = (size_t)row * DMODEL + col0 + bj * HALF; f32x4 b0, b1;
                    if constexpr (BASEF32) { b0 = *(const f32x4*)((const float*)base + off); b1 = *(const f32x4*)((const float*)base + off + 4); }
                    else { const u32x4 w = *(const u32x4*)((const bf16_t*)base + off);
                        b0 = (f32x4){__uint_as_float(w.x << 16), __uint_as_float(w.x & 0xFFFF0000u), __uint_as_float(w.y << 16), __uint_as_float(w.y & 0xFFFF0000u)};
                        b1 = (f32x4){__uint_as_float(w.z << 16), __uint_as_float(w.z & 0xFFFF0000u), __uint_as_float(w.w << 16), __uint_as_float(w.w & 0xFFFF0000u)}; }
                    const f32x4 v0 = acc[ai][bj][m][0] * ascale + b0, v1 = acc[ai][bj][m][1] * ascale + b1;
                    { u32x4 w; w.x = pkbf(v0[0], v0[1]); w.y = pkbf(v0[2], v0[3]); w.z = pkbf(v1[0], v1[1]); w.w = pkbf(v1[2], v1[3]); *(u32x4*)(out + off) = w; }
                    if (hb8) { u32x2 w; w.x = pk4f8(v0[0], v0[1], v0[2], v0[3]); w.y = pk4f8(v1[0], v1[1], v1[2], v1[3]); *(u32x2*)(hb8 + off) = w; }
                    sq += (v0[0] * v0[0] + v0[1] * v0[1]) + (v0[2] * v0[2] + v0[3] * v0[3]) + (v1[0] * v1[0] + v1[1] * v1[1]) + (v1[2] * v1[2] + v1[3] * v1[3]); }
                sq = xsum_rows(sq);
                if (fq == 0) ssq[(size_t)row * SSQ_PARTS + u.pn * 4 + wc] = sq; }
    }
};
struct EpiAin {
    static constexpr bool PERM = true, AFTER_DRAIN = false;
    bf16_t *Q, *K, *V, *QI, *KI; float* WI; const float* ssq; const float* cosT; const float* sinT; float qscale, wscale; int pn_off;
    __device__ __forceinline__ void operator()(const f32x4 (&acc)[2][2][4][2], const Unit& u, int wr, int wc, int fr, int fq) const {
        const int row0 = u.pm * BM + wr * 64 + fr;
        const int pn = u.pn + pn_off;
        if (pn >= 8 && pn < 12) {
            const int col0 = (pn - 8) * BM + wc * 32 + 8 * fq;
#pragma unroll
            for (int ai = 0; ai < 2; ++ai) { float rs[4]; rstd_half(ssq, row0 + ai * HALF, fq, wscale, rs);
#pragma unroll
                for (int m = 0; m < 4; ++m) { const int row = row0 + ai * HALF + m * 16; const float r = rs[m];
#pragma unroll
                    for (int bj = 0; bj < 2; ++bj) { const f32x4 v0 = acc[ai][bj][m][0] * r, v1 = acc[ai][bj][m][1] * r;
                        u32x4 w; w.x = pkbf(v0[0], v0[1]); w.y = pkbf(v0[2], v0[3]); w.z = pkbf(v1[0], v1[1]); w.w = pkbf(v1[2], v1[3]);
                        *(u32x4*)(V + (size_t)row * DMODEL + col0 + bj * HALF) = w; } }
                asm volatile("" ::: "memory"); }
            return;
        }
        bf16_t* dst; int pitch, colbase; float sc = 1.f;
        if (pn < 4) { dst = Q; pitch = DMODEL; colbase = pn * BM; sc = qscale; }
        else if (pn < 8) { dst = K; pitch = DMODEL; colbase = (pn - 4) * BM; }
        else if (pn < 14) { dst = QI; pitch = 512; colbase = (pn - 12) * BM; }
        else { dst = KI; pitch = 64; colbase = 0; }
        const int g = 4 * (wc & 1) + fq;
#pragma unroll
        for (int ai = 0; ai < 2; ++ai) { float rs[4]; rstd_half(ssq, row0 + ai * HALF, fq, wscale, rs);
#pragma unroll
            for (int m = 0; m < 4; ++m) { const int row = row0 + ai * HALF + m * 16; const float r = rs[m] * sc; const int t = row & 8191;
                const f32x4 c4 = *(const f32x4*)(cosT + t * 32 + 4 * g), s4 = *(const f32x4*)(sinT + t * 32 + 4 * g);
#pragma unroll
                for (int bj = 0; bj < 2; ++bj) { const int cit = bj * HALF + wc * 32;
                    const f32x4 x1 = acc[ai][bj][m][0] * r, x2 = acc[ai][bj][m][1] * r;
                    if (pn == 14) {
                        if (cit == 64 && fq == 0) { const float ws = 0.35355339059327373f; *(f32x4*)(WI + (size_t)row * 8) = acc[ai][bj][m][0] * (rs[m] * ws); *(f32x4*)(WI + (size_t)row * 8 + 4) = acc[ai][bj][m][1] * (rs[m] * ws); }
                        if (cit >= 64) continue;
                    }
                    const f32x4 y1 = x1 * c4 - x2 * s4, y2 = x2 * c4 + x1 * s4;
                    bf16_t* p = dst + (size_t)row * pitch + colbase + (cit & ~63) + 4 * g;
                    u32x2 w1, w2; w1.x = pkbf(y1[0], y1[1]); w1.y = pkbf(y1[2], y1[3]); w2.x = pkbf(y2[0], y2[1]); w2.y = pkbf(y2[2], y2[3]);
                    *(u32x2*)p = w1; *(u32x2*)(p + 32) = w2; } }
            asm volatile("" ::: "memory"); }
    }
};
__device__ __forceinline__ float logsig(float x) { const float e = __builtin_amdgcn_exp2f(-fabsf(x) * 1.4426950408889634f); return fminf(x, 0.f) - __builtin_amdgcn_logf(1.0f + e) * 0.6931471805599453f; }
struct EpiKVQ {
    static constexpr bool PERM = true, AFTER_DRAIN = false;
    bf16_t* QKV; size_t stride; float* LOGF; const float* bf; const float* ssq; float qscale, wscale;
    __device__ __forceinline__ void operator()(const f32x4 (&acc)[2][2][4][2], const Unit& u, int wr, int wc, int fr, int fq) const {
        const int row0 = u.pm * BM + wr * 64 + fr;
        const int pn = u.pn;
        if (pn == 12) {
            if (wc == 0 && fq < 2) {
                const f32x4 b0 = *(const f32x4*)(bf + 8 * fq), b1 = *(const f32x4*)(bf + 8 * fq + 4);
#pragma unroll
                for (int ai = 0; ai < 2; ++ai) { float rs[4];
#pragma unroll
                    for (int m = 0; m < 4; ++m) { float s = 0.f;
#pragma unroll
                        for (int q = 0; q < 4; ++q) { const f32x4 p = *(const f32x4*)(ssq + (size_t)(row0 + ai * HALF + m * 16) * SSQ_PARTS + 4 * q); s += (p[0] + p[1]) + (p[2] + p[3]); }
                        rs[m] = wscale / sqrtf(s * (1.0f / DMODEL) + RMS_EPS_F); }
#pragma unroll
                    for (int m = 0; m < 4; ++m) { const int row = row0 + ai * HALF + m * 16; const float r = rs[m];
                        const f32x4 x0 = acc[ai][0][m][0] * r + b0, x1 = acc[ai][0][m][1] * r + b1;
                        const f32x4 o0 = {logsig(x0[0]), logsig(x0[1]), logsig(x0[2]), logsig(x0[3])}, o1 = {logsig(x1[0]), logsig(x1[1]), logsig(x1[2]), logsig(x1[3])};
                        *(f32x4*)(LOGF + (size_t)row * 16 + 8 * fq) = o0; *(f32x4*)(LOGF + (size_t)row * 16 + 8 * fq + 4) = o1; } }
            }
            return;
        }
        bf16_t* dst = QKV + (size_t)(pn >> 2) * stride; const float sc = pn < 4 ? qscale : 1.f;
        const int col0 = (pn & 3) * BM + wc * 32 + 8 * fq;
#pragma unroll
        for (int ai = 0; ai < 2; ++ai) { float rs[4]; rstd_half(ssq, row0 + ai * HALF, fq, wscale * sc, rs);
#pragma unroll
            for (int m = 0; m < 4; ++m) { const int row = row0 + ai * HALF + m * 16; const float r = rs[m];
#pragma unroll
                for (int bj = 0; bj < 2; ++bj) { const f32x4 v0 = acc[ai][bj][m][0] * r, v1 = acc[ai][bj][m][1] * r;
                    u32x4 w; w.x = pkbf(v0[0], v0[1]); w.y = pkbf(v0[2], v0[3]); w.z = pkbf(v1[0], v1[1]); w.w = pkbf(v1[2], v1[3]);
                    *(u32x4*)(dst + (size_t)row * DMODEL + col0 + bj * HALF) = w; } }
            asm volatile("" ::: "memory"); }
    }
};
struct EpiSwiglu {
    static constexpr bool PERM = true, AFTER_DRAIN = false;
    unsigned char* ACT; const float* ssq; const float* rsd; int nN; float wscale; int dry;
    __device__ __forceinline__ void operator()(const f32x4 (&acc)[2][2][4][2], const Unit& u, int wr, int wc, int fr, int fq) const {
        const int row0 = u.pm * BM + wr * 64 + fr;
        const int pnl = u.pn % nN, col0 = pnl * 128 + wc * 16 + 4 * fq;
#pragma unroll
        for (int ai = 0; ai < 2; ++ai) {
            float rs[4];
#pragma unroll
            for (int m = 0; m < 4; ++m) { const int row = row0 + ai * HALF + m * 16;
                if (ssq) { const f32x4 p = *(const f32x4*)(ssq + (size_t)row * SSQ_PARTS + 4 * fq); float s = (p[0] + p[1]) + (p[2] + p[3]); s = xsum_rows(s); rs[m] = wscale / sqrtf(s * (1.0f / DMODEL) + RMS_EPS_F); }
                else rs[m] = rsd[row] * wscale; }
#pragma unroll
            for (int m = 0; m < 4; ++m) { const int row = row0 + ai * HALF + m * 16; const float r = rs[m];
#pragma unroll
                for (int bj = 0; bj < 2; ++bj) { const f32x4 gg = acc[ai][bj][m][0] * r, uu = acc[ai][bj][m][1] * r; f32x4 a;
#pragma unroll
                    for (int i = 0; i < 4; ++i) a[i] = gg[i] * __builtin_amdgcn_rcpf(1.0f + __builtin_amdgcn_exp2f(gg[i] * -1.4426950408889634f)) * uu[i];
                    const unsigned pk_ = pk4f8(a[0], a[1], a[2], a[3]); if (!dry) *(unsigned*)(ACT + (size_t)row * 2816 + col0 + bj * 64) = pk_; else asm volatile("" :: "v"(pk_)); } }
            asm volatile("" ::: "memory");
        }
    }
};
struct EpiMoeDown {
    static constexpr bool PERM = true, AFTER_DRAIN = false;
    bf16_t* Y; const float* gate; float ascale;
    __device__ __forceinline__ void operator()(const f32x4 (&acc)[2][2][4][2], const Unit& u, int wr, int wc, int fr, int fq) const {
        const int row0 = u.pm * BM + wr * 64 + fr, col0 = (u.pn & 3) * BM + wc * 32 + 8 * fq;
#pragma unroll
        for (int ai = 0; ai < 2; ++ai)
#pragma unroll
            for (int m = 0; m < 4; ++m) { const int row = row0 + ai * HALF + m * 16; const float r = gate[row] * ascale;
#pragma unroll
                for (int bj = 0; bj < 2; ++bj) { const f32x4 v0 = acc[ai][bj][m][0] * r, v1 = acc[ai][bj][m][1] * r;
                    u32x4 w; w.x = pkbf(v0[0], v0[1]); w.y = pkbf(v0[2], v0[3]); w.z = pkbf(v1[0], v1[1]); w.w = pkbf(v1[2], v1[3]);
                    *(u32x4*)(Y + (size_t)row * DMODEL + col0 + bj * HALF) = w; } }
    }
};
struct GroupedOrder {
    int nu; const PG8_LAS int* tbl;
    __device__ __forceinline__ void init(const unsigned* cnt, int nN, int G, int c, PG8_LAS int* tb_lds, bool tid0) {
        int tb[9]; tb[0] = 0;
#pragma unroll
        for (int e = 0; e < 8; ++e) tb[e + 1] = tb[e] + (int)((__builtin_amdgcn_readfirstlane(cnt[e]) + 255u) >> 8);
        const int T = tb[8], nwg = T * nN; int n = 0;
        for (int i = 0; i < 32; ++i) {
            const long L = (long)i * G + c; if (L >= nwg) break;
            int wgid = (int)L; { const int q = nwg / NXCD, r = nwg % NXCD, xcd = wgid % NXCD, off = wgid / NXCD; wgid = (xcd < r ? xcd * (q + 1) : r * (q + 1) + (xcd - r) * q) + off; }
            const int nig = WGM * nN, gid = wgid / nig, fm = gid * WGM, gsz = (T - fm) < WGM ? (T - fm) : WGM;
            const int pm = fm + ((wgid % nig) % gsz), pnl = (wgid % nig) / gsz; int e = 0;
#pragma unroll
            for (int k = 1; k < 8; ++k) e += (pm >= tb[k]) ? 1 : 0;
            if (tid0) { tb_lds[2 * i] = pm; tb_lds[2 * i + 1] = e * nN + pnl; }
            n = i + 1;
        }
        nu = n; tbl = tb_lds;
        __syncthreads();
    }
    __device__ __forceinline__ bool next(int i, Unit& u) const {
        if (i >= nu) return false;
        u.pm = __builtin_amdgcn_readfirstlane(tbl[2 * i]); u.pn = __builtin_amdgcn_readfirstlane(tbl[2 * i + 1]); return true;
    }
    __device__ __forceinline__ void a_ready(const Unit&) const {}
    __device__ __forceinline__ void done(const Unit&) const {}
};
__device__ __forceinline__ int pg8_lane() { int l; asm volatile("v_mbcnt_lo_u32_b32 %0, -1, 0\n\tv_mbcnt_hi_u32_b32 %0, -1, %0" : "=v"(l)); return l; }
__device__ __forceinline__ void pg8_dma16(unsigned voff, const void* sbase, unsigned lds_dst) { unsigned keep;
    asm volatile("s_mov_b32 %0, m0\n\ts_mov_b32 m0, %3\n\ts_nop 0\n\tglobal_load_lds_dwordx4 %1, %2\n\ts_mov_b32 m0, %0" : "=&s"(keep) : "v"(voff), "s"(sbase), "s"(lds_dst) : "memory"); }
template <class Epi, class Sched, bool ALIGN_EPI = false, bool SP2 = false, int FMT = 0>
__device__ __forceinline__ void gemm_phase(PG8_LAS unsigned char* lds, const Gemm g, const Sched& S, const Epi& E, const int wv  ) {
    const int wid = wv, lane = pg8_lane(), tid = wid * 64 + lane, wr = wid >> 2, wc = wid & 3, fr = lane & 15, fq = lane >> 4;
    const int K = g.K, nt = K / BK;
    unsigned voffA[2], voffB[2];
#pragma unroll
    for (int i = 0; i < 2; ++i) { int R, C; stage_rc(tid * 16 + i * 8192, R, C); const int Rb = Epi::PERM ? ((R & ~31) + perm32(R & 31)) : R;
        voffA[i] = (unsigned)(R * K + C) * 2u; voffB[i] = (unsigned)(Rb * K + C) * 2u; }
    const size_t kstep = (size_t)(BK * 2);
    const size_t hstep = (size_t)HALF * K * 2;
    const size_t tstep = 2 * hstep;
    const unsigned lds0 = (unsigned)(unsigned long long)lds; const size_t rstep64 = (size_t)64 * K * 2;
    const unsigned ldsw = (unsigned)wid * 1024u;
    const int aoff = lds_byte(wr * 64 + fr, fq * 8), boff = lds_byte(wc * 32 + fr, fq * 8);
#define PG8_SA(b, h) (((b) * 2 + (h)) * HTB)
#define PG8_SB(b, h) ((4 + (b) * 2 + (h)) * HTB)
#define PG8_STAGE(bufoff, gbase, voff) do { _Pragma("unroll") for (int _i = 0; _i < 2; ++_i) \
        pg8_dma16((voff)[0], (const char*)(gbase) + (size_t)_i * rstep64, lds0 + (unsigned)((bufoff) + _i * 8192) + ldsw); } while (0)
#define PG8_LDA(dst, b, h) do { _Pragma("unroll") for (int m = 0; m < 4; ++m) _Pragma("unroll") for (int k = 0; k < 2; ++k) dst[m][k] = *(const PG8_LAS bf16x8*)(lds + PG8_SA(b, h) + aoff + m * 2048 + k * 1024); } while (0)
#define PG8_LDB(dst, b, h) do { _Pragma("unroll") for (int n = 0; n < 2; ++n) _Pragma("unroll") for (int k = 0; k < 2; ++k) dst[n][k] = *(const PG8_LAS bf16x8*)(lds + PG8_SB(b, h) + boff + n * 2048 + k * 1024); } while (0)
#define PG8_CAT8(x) __builtin_shufflevector(__builtin_bit_cast(i32x4, (x)[0]), __builtin_bit_cast(i32x4, (x)[1]), 0, 1, 2, 3, 4, 5, 6, 7)
#define PG8_MMA(ai, bj, At, Bt) do { if constexpr (FMT == 1) __builtin_amdgcn_sched_barrier(0); __builtin_amdgcn_s_setprio(1); \
    if constexpr (FMT == 1) { _Pragma("unroll") for (int m = 0; m < 4; ++m) _Pragma("unroll") for (int n = 0; n < 2; ++n) \
        acc[ai][bj][m][n] = __builtin_amdgcn_mfma_scale_f32_16x16x128_f8f6f4(PG8_CAT8(Bt[n]), PG8_CAT8(At[m]), acc[ai][bj][m][n], 0, 0, 0, 0x7F7F7F7F, 0, 0x7F7F7F7F); } \
    else { _Pragma("unroll") for (int m = 0; m < 4; ++m) _Pragma("unroll") for (int n = 0; n < 2; ++n) _Pragma("unroll") for (int k = 0; k < 2; ++k) \
        acc[ai][bj][m][n] = __builtin_amdgcn_mfma_f32_16x16x32_bf16(Bt[n][k], At[m][k], acc[ai][bj][m][n], 0, 0, 0); } __builtin_amdgcn_s_setprio(0); if constexpr (FMT == 1) __builtin_amdgcn_sched_barrier(0); } while (0)
#define PG8_WAIT_V(n) asm volatile("s_waitcnt vmcnt(" #n ")" ::: "memory")
#define PG8_WAIT_L(n) asm volatile("s_waitcnt lgkmcnt(" #n ")" ::: "memory")
#define PG8_BAR __builtin_amdgcn_s_barrier()
#define PG8_SCHED __builtin_amdgcn_sched_barrier(0)
    Unit cur, nxt; int ui = 0;
    if (!S.next(0, cur)) return;
    f32x4 acc[2][2][4][2];
#pragma unroll
    for (int a = 0; a < 2; ++a)
#pragma unroll
        for (int b = 0; b < 2; ++b)
#pragma unroll
            for (int m = 0; m < 4; ++m)
#pragma unroll
                for (int n = 0; n < 2; ++n) acc[a][b][m][n] = (f32x4){0.f, 0.f, 0.f, 0.f};
    bf16x8 At[4][2], B0[2][2], B1[2][2];
    const char* cA = (const char*)g.A + (size_t)cur.pm * tstep; const char* cB = (const char*)g.Bt + (size_t)cur.pn * tstep;
    S.a_ready(cur);
    if constexpr (SP2) {
        PG8_STAGE(PG8_SB(0, 0), cB, voffB); PG8_STAGE(PG8_SB(0, 1), cB + hstep, voffB); PG8_STAGE(PG8_SA(0, 0), cA, voffA); PG8_STAGE(PG8_SA(0, 1), cA + hstep, voffA);
        if (wr == 1) PG8_BAR;
        PG8_WAIT_V(2); PG8_BAR;
        PG8_STAGE(PG8_SB(1, 0), cB + kstep, voffB); PG8_STAGE(PG8_SA(1, 0), cA + kstep, voffA); PG8_STAGE(PG8_SB(1, 1), cB + hstep + kstep, voffB);
        PG8_WAIT_V(6); PG8_BAR;
    } else {
        PG8_STAGE(PG8_SB(0, 0), cB, voffB); PG8_STAGE(PG8_SA(0, 0), cA, voffA); PG8_STAGE(PG8_SB(0, 1), cB + hstep, voffB); PG8_STAGE(PG8_SA(0, 1), cA + hstep, voffA);
        if (wr == 1) PG8_BAR;
        PG8_WAIT_V(4); PG8_BAR;
        PG8_STAGE(PG8_SB(1, 0), cB + kstep, voffB); PG8_STAGE(PG8_SA(1, 0), cA + kstep, voffA); PG8_STAGE(PG8_SB(1, 1), cB + hstep + kstep, voffB);
        PG8_WAIT_V(6); PG8_BAR;
    }
    for (;;) {
        const bool has_next = S.next(ui + 1, nxt);
        const char* nA = has_next ? (const char*)g.A + (size_t)nxt.pm * tstep : cA; const char* nB = has_next ? (const char*)g.Bt + (size_t)nxt.pn * tstep : cB;
        for (int t = 0; t < nt; t += 2) {
            const bool last = (t == nt - 2);
            const char* a1 = cA + (size_t)(t + 1) * kstep;
            const char* a2 = last ? nA : cA + (size_t)(t + 2) * kstep; const char* b2 = last ? nB : cB + (size_t)(t + 2) * kstep;
            const char* a3 = a2 + kstep; const char* b3 = b2 + kstep;
            if (last && has_next) S.a_ready(nxt);
            if constexpr (SP2) {
            PG8_LDB(B0, 0, 0); PG8_LDB(B1, 0, 1); PG8_SCHED; PG8_LDA(At, 0, 0); PG8_STAGE(PG8_SA(1, 1), a1 + hstep, voffA);
            PG8_WAIT_V(8); PG8_WAIT_L(0); PG8_BAR; PG8_MMA(0, 0, At, B0); PG8_MMA(0, 1, At, B1); PG8_BAR; PG8_SCHED;
            PG8_LDA(At, 0, 1); PG8_STAGE(PG8_SB(0, 0), b2, voffB); PG8_STAGE(PG8_SB(0, 1), b2 + hstep, voffB); PG8_STAGE(PG8_SA(0, 0), a2, voffA);
            PG8_WAIT_V(8); PG8_WAIT_L(0); PG8_BAR; PG8_MMA(1, 0, At, B0); PG8_MMA(1, 1, At, B1); PG8_BAR; PG8_SCHED;
            PG8_LDB(B0, 1, 0); PG8_LDB(B1, 1, 1); PG8_SCHED; PG8_LDA(At, 1, 0); PG8_STAGE(PG8_SA(0, 1), a2 + hstep, voffA);
            PG8_WAIT_V(8); PG8_WAIT_L(0); PG8_BAR; PG8_MMA(0, 0, At, B0); PG8_MMA(0, 1, At, B1); PG8_BAR; PG8_SCHED;
            PG8_LDA(At, 1, 1); PG8_STAGE(PG8_SB(1, 0), b3, voffB); PG8_STAGE(PG8_SB(1, 1), b3 + hstep, voffB); PG8_STAGE(PG8_SA(1, 0), a3, voffA);
            PG8_WAIT_V(8); PG8_WAIT_L(0); PG8_BAR; PG8_MMA(1, 0, At, B0); PG8_MMA(1, 1, At, B1); PG8_BAR; PG8_SCHED;
            } else {
            PG8_LDB(B0, 0, 0); PG8_SCHED; PG8_LDA(At, 0, 0); PG8_STAGE(PG8_SA(1, 1), a1 + hstep, voffA);
            PG8_WAIT_L(8); PG8_BAR; PG8_WAIT_L(0); PG8_MMA(0, 0, At, B0); PG8_BAR; PG8_SCHED;
            PG8_LDB(B1, 0, 1); PG8_STAGE(PG8_SB(0, 0), b2, voffB);
            PG8_BAR; PG8_WAIT_L(0); PG8_MMA(0, 1, At, B1); PG8_BAR;
            PG8_LDA(At, 0, 1); PG8_STAGE(PG8_SA(0, 0), a2, voffA);
            PG8_BAR; PG8_WAIT_L(0); PG8_MMA(1, 0, At, B0); PG8_BAR; PG8_SCHED;
            PG8_STAGE(PG8_SB(0, 1), b2 + hstep, voffB);
            PG8_WAIT_V(6); PG8_BAR; PG8_MMA(1, 1, At, B1); PG8_BAR;
            PG8_LDB(B0, 1, 0); PG8_SCHED; PG8_LDA(At, 1, 0); PG8_STAGE(PG8_SA(0, 1), a2 + hstep, voffA);
            PG8_WAIT_L(8); PG8_BAR; PG8_WAIT_L(0); PG8_MMA(0, 0, At, B0); PG8_BAR; PG8_SCHED;
            PG8_LDB(B1, 1, 1); PG8_STAGE(PG8_SB(1, 0), b3, voffB);
            PG8_BAR; PG8_WAIT_L(0); PG8_MMA(0, 1, At, B1); PG8_BAR;
            PG8_LDA(At, 1, 1); PG8_STAGE(PG8_SA(1, 0), a3, voffA);
            PG8_BAR; PG8_WAIT_L(0); PG8_MMA(1, 0, At, B0); PG8_BAR; PG8_SCHED;
            PG8_STAGE(PG8_SB(1, 1), b3 + hstep, voffB);
            PG8_WAIT_V(6); PG8_BAR; PG8_MMA(1, 1, At, B1); PG8_BAR;
            }
        }
        if constexpr (ALIGN_EPI) { if (wr == 0) PG8_BAR; }
        if constexpr (!Epi::AFTER_DRAIN) { const int l2_ = pg8_lane(), w2_ = wv;
            E(acc, cur, w2_ >> 2, w2_ & 3, l2_ & 15, l2_ >> 4); S.done(cur); }
        if (!has_next) break;
#pragma unroll
        for (int a = 0; a < 2; ++a)
#pragma unroll
            for (int b = 0; b < 2; ++b)
#pragma unroll
                for (int m = 0; m < 4; ++m)
#pragma unroll
                    for (int n = 0; n < 2; ++n) acc[a][b][m][n] = (f32x4){0.f, 0.f, 0.f, 0.f};
        cur = nxt; cA = nA; cB = nB; ++ui;
        if constexpr (ALIGN_EPI) { if (wr == 1) PG8_BAR; }
    }
    PG8_WAIT_V(0);
    if constexpr (!ALIGN_EPI) { if (wr == 0) PG8_BAR; }
    PG8_BAR;
    if constexpr (Epi::AFTER_DRAIN) { E.fused(acc, cur, wr, wc, fr, fq, lds, wid, lane); S.done(cur); }
#undef PG8_SA
#undef PG8_SB
#undef PG8_STAGE
#undef PG8_LDA
#undef PG8_LDB
#undef PG8_MMA
#undef PG8_CAT8
#undef PG8_WAIT_V
#undef PG8_WAIT_L
#undef PG8_BAR
#undef PG8_SCHED
}
}
#include <hip/hip_bf16.h>
#include <cmath>
namespace attn_body {
using bf16=__hip_bfloat16;
using bf16x8=__attribute__((ext_vector_type(8)))short;
using s16x4=__attribute__((ext_vector_type(4)))short;
using f32x16=__attribute__((ext_vector_type(16)))float;
using u32x4=__attribute__((ext_vector_type(4)))unsigned;
using f32x4v=__attribute__((ext_vector_type(4)))float;
constexpr int BATCH=2,NHEAD=16,SEQ=8192,D=64,DM=NHEAD*D;
constexpr int NW=8,QBLK=32,QB=QBLK*NW,KVBLK=64,NQB=SEQ/QB;
constexpr int ATTN_PITCH=DM, ATTN_UNIT_ROWS=QB;
__device__ __forceinline__ int crow(int r,int hi){return (r&3)+8*(r>>2)+4*hi;}
#define SBAR() __builtin_amdgcn_sched_barrier(0)
__device__ __forceinline__ void cmask(f32x16&p0,f32x16&p1,int jb,int qrel,int hi){
  int d=qrel-(64*jb+4*hi); asm volatile("":"+v"(d));
  #pragma unroll
  for(int r=0;r<16;++r){const int c=(r&3)+8*(r>>2); const unsigned m0=(unsigned)((d-c)>>31), m1=(unsigned)((d-c-32)>>31);
    p0[r]=__uint_as_float((m0&0xff800000u)|(~m0&__float_as_uint(p0[r]))); p1[r]=__uint_as_float((m1&0xff800000u)|(~m1&__float_as_uint(p1[r])));}
}

constexpr bool FOX_GUARD=true;
constexpr int SKIP_LOG2=200;
constexpr int NSLOT=3, SLOTB=8192;
constexpr int LDS_K=0, LDS_V=NSLOT*SLOTB, LDS_WS=2*NSLOT*SLOTB, LDS_OST=LDS_WS+NW*64*4, LDS_ATT=LDS_OST+NW*4096, LDS_GK=LDS_ATT, LDS_BYTES=LDS_ATT+(SEQ+QB)*4;
constexpr float C2=0.125f*1.4426950408889634f;
__device__ __forceinline__ void glds16(const void*gsrc,unsigned lds_dst){unsigned keep;
  asm volatile("s_mov_b32 %0, m0\n\ts_mov_b32 m0, %2\n\ts_nop 0\n\tglobal_load_lds_dwordx4 %1, off\n\ts_mov_b32 m0, %0":"=&s"(keep):"v"(gsrc),"s"(lds_dst):"memory");}
__device__ __forceinline__ void glds4(const void*gsrc,unsigned lds_dst){unsigned keep;
  asm volatile("s_mov_b32 %0, m0\n\ts_mov_b32 m0, %2\n\ts_nop 0\n\tglobal_load_lds_dword %1, off\n\ts_mov_b32 m0, %0":"=&s"(keep):"v"(gsrc),"s"(lds_dst):"memory");}
__device__ __forceinline__ float max3f(float a,float b,float c){float r;asm("v_max3_f32 %0, %1, %2, %3":"=v"(r):"v"(a),"v"(b),"v"(c));return r;}
__device__ __forceinline__ float max2f(float a,float b){float r;asm("v_max_f32_e32 %0, %1, %2":"=v"(r):"v"(a),"v"(b));return r;}
__device__ __forceinline__ float fadd_s(float a,float b){float r;asm("v_add_f32_e32 %0, %1, %2":"=v"(r):"v"(a),"v"(b));return r;}
__device__ __forceinline__ float fsub_s(float a,float b){float r;asm("v_sub_f32_e32 %0, %1, %2":"=v"(r):"v"(a),"v"(b));return r;}
typedef float f32x2_t __attribute__((ext_vector_type(2))); typedef __bf16 bf16x2_t __attribute__((ext_vector_type(2)));
__device__ __forceinline__ unsigned cvtpk_s(float lo,float hi){f32x2_t v={lo,hi};bf16x2_t b=__builtin_convertvector(v,bf16x2_t);return __builtin_bit_cast(unsigned,b);}
#define WAIT_BAR(N) asm volatile("s_waitcnt vmcnt(" #N ") lgkmcnt(0)\n\ts_barrier":::"memory")

template<bool ACC> __device__ __forceinline__ void qkt(f32x16&p0,f32x16&p1,const char*Kslot,const bf16x8*qr,const f32x16&negm,int r32,int hi){
  const char*kb=Kslot+hi*1024+r32*16;
  #pragma unroll
  for(int d0=0;d0<4;++d0){
    const bf16x8 b0=*reinterpret_cast<const bf16x8*>(kb+d0*2048);
    const bf16x8 b1=*reinterpret_cast<const bf16x8*>(kb+d0*2048+512);
    if(d0==0&&!ACC){p0=__builtin_amdgcn_mfma_f32_32x32x16_bf16(b0,qr[0],negm,0,0,0);p1=__builtin_amdgcn_mfma_f32_32x32x16_bf16(b1,qr[0],negm,0,0,0);}
    else{p0=__builtin_amdgcn_mfma_f32_32x32x16_bf16(b0,qr[d0],p0,0,0,0);p1=__builtin_amdgcn_mfma_f32_32x32x16_bf16(b1,qr[d0],p1,0,0,0);}}
}
typedef __attribute__((address_space(3))) const char* lds_cptr;
typedef short v4i16_t __attribute__((ext_vector_type(4)));
__device__ __forceinline__ void kload8(bf16x8*kf,lds_cptr kp){
  kf[0]=*(const __attribute__((address_space(3))) bf16x8*)(kp);      kf[1]=*(const __attribute__((address_space(3))) bf16x8*)(kp+512);
  kf[2]=*(const __attribute__((address_space(3))) bf16x8*)(kp+2048); kf[3]=*(const __attribute__((address_space(3))) bf16x8*)(kp+2560);
  kf[4]=*(const __attribute__((address_space(3))) bf16x8*)(kp+4096); kf[5]=*(const __attribute__((address_space(3))) bf16x8*)(kp+4608);
  kf[6]=*(const __attribute__((address_space(3))) bf16x8*)(kp+6144); kf[7]=*(const __attribute__((address_space(3))) bf16x8*)(kp+6656);
}
__device__ __forceinline__ void kload2(bf16x8*kf,lds_cptr kp,int j){ kf[2*j]=*(const __attribute__((address_space(3))) bf16x8*)(kp+j*2048); kf[2*j+1]=*(const __attribute__((address_space(3))) bf16x8*)(kp+j*2048+512); }
__device__ __forceinline__ s16x4 vtr(lds_cptr p){ return __builtin_bit_cast(s16x4,__builtin_amdgcn_ds_read_tr16_b64_v4i16((__attribute__((address_space(3))) v4i16_t*)p)); }
__device__ __forceinline__ float rowmax(const f32x16&p0,const f32x16&p1){
  float a=max3f(p0[0],p0[1],p1[0]),b=max3f(p0[2],p0[3],p1[1]);a=max3f(a,p1[2],p1[3]);
  #pragma unroll
  for(int r=4;r<16;r+=4){a=max3f(a,p0[r],p0[r+1]);b=max3f(b,p0[r+2],p0[r+3]);a=max3f(a,p1[r],p1[r+1]);b=max3f(b,p1[r+2],p1[r+3]);}
  const float m=max2f(a,b);
  auto rr=__builtin_amdgcn_permlane32_swap(__float_as_uint(m),__float_as_uint(m),false,false);
  return max2f(__uint_as_float(rr[0]),__uint_as_float(rr[1]));
}
__device__ __forceinline__ void pv(f32x16*o,int vb,bf16x8 pa0,bf16x8 pa1,bf16x8 pa2,bf16x8 pa3){
  #pragma unroll
  for(int d0=0;d0<2;++d0){s16x4 lo[4],hi[4];
    #pragma unroll
    for(int ks=0;ks<4;++ks){
      asm volatile("ds_read_b64_tr_b16 %0,%1 offset:%c2":"=&v"(lo[ks]):"v"(vb),"i"(d0*4096+ks*1024):"memory");
      asm volatile("ds_read_b64_tr_b16 %0,%1 offset:%c2":"=&v"(hi[ks]):"v"(vb),"i"(d0*4096+ks*1024+512):"memory");}
    asm volatile("s_waitcnt lgkmcnt(0)":::"memory");SBAR();
    #define PK(k) (bf16x8){lo[k][0],lo[k][1],lo[k][2],lo[k][3],hi[k][0],hi[k][1],hi[k][2],hi[k][3]}
    o[d0]=__builtin_amdgcn_mfma_f32_32x32x16_bf16(pa0,PK(0),o[d0],0,0,0);
    o[d0]=__builtin_amdgcn_mfma_f32_32x32x16_bf16(pa1,PK(1),o[d0],0,0,0);
    o[d0]=__builtin_amdgcn_mfma_f32_32x32x16_bf16(pa2,PK(2),o[d0],0,0,0);
    o[d0]=__builtin_amdgcn_mfma_f32_32x32x16_bf16(pa3,PK(3),o[d0],0,0,0);
    #undef PK
  }
}

#ifndef ATTN_STORE16
#define ATTN_STORE16(p,v) (*(u32x4*)(p)=(v))
#endif
template<int MODE,int THRL> __device__ __forceinline__ void attn_unit(int b,int h,int qb,const bf16*Q,const bf16*__restrict__ K,const bf16*__restrict__ V,bf16*O,char*shm,const float*GKg,const unsigned long long*MKT,const int wv){
  int lane_; asm volatile("v_mbcnt_lo_u32_b32 %0, -1, 0\n\tv_mbcnt_hi_u32_b32 %0, -1, %0":"=v"(lane_)); const int wid=wv,lane=lane_,tid=wid*64+lane,r32=lane&31,hi=lane>>5;
  const long rowbase=(long)b*SEQ; const int q0=qb*QB;
  const bf16*Qw=Q+(rowbase+q0+wid*QBLK)*DM+h*D;
  int kt0=0;
  if constexpr(MODE==0){ const float*gsrc=GKg+(size_t)(b*NHEAD+h)*SEQ; const int te=2*lane; const bool live=(te<=(q0+QB)/KVBLK-4)&&(gsrc[((te+1)<(q0+QB)/KVBLK?(te+1):0)*KVBLK+KVBLK-1]-gsrc[q0]>=-(float)SKIP_LOG2);
    const unsigned long long bal=__ballot(live); const int first=bal?__builtin_ctzll(bal):0; kt0=2*first; const int cap=(q0+QB)/KVBLK-4; kt0=kt0<cap?kt0:cap; kt0=__builtin_amdgcn_readfirstlane(kt0); }
  const bf16*Kh=K+(rowbase+(long)kt0*KVBLK)*DM+h*D,*Vh=V+(rowbase+(long)kt0*KVBLK)*DM+h*D;
  const lds_cptr shm3=(lds_cptr)shm;
  const unsigned lds0=(unsigned)(uintptr_t)shm;
  float*wsf=(float*)(shm+LDS_WS)+wid*64;
  const bf16*ksrc=Kh+(long)lane*DM+wid*8;
  const bf16*vsrc=Vh+(long)(16*(wid&3)+(lane>>2))*DM+(wid>>2)*32+(lane&3)*8;
  const unsigned kdst=lds0+LDS_K+wid*1024, vdst=lds0+LDS_V+wid*1024;
  #define DMA_K(t,slot) glds16(ksrc+(long)(t)*KVBLK*DM,(unsigned)__builtin_amdgcn_readfirstlane(kdst+(slot)))
  #define DMA_V(t,slot) glds16(vsrc+(long)(t)*KVBLK*DM,(unsigned)__builtin_amdgcn_readfirstlane(vdst+(slot)))
  const int vb0=(int)(lds0+LDS_V)+((lane>>4)&1)*32+(lane&3)*8+(4*hi+((lane&15)>>2))*64;
  const char*Kbase=shm+LDS_K; bf16x8 kf[8];
  const lds_cptr kp0=shm3+LDS_K+hi*1024+r32*16; const lds_cptr vp0=shm3+LDS_V+((lane>>4)&1)*32+(lane&3)*8+(4*hi+((lane&15)>>2))*64;
  const int NT=(q0+QB)/KVBLK-kt0;
  const int qrel=wid*QBLK+r32;
  #define MLOAD(t) glds4(msrc+(size_t)(t)*(SEQ*2),(unsigned)__builtin_amdgcn_readfirstlane(mdst+(((t)&1)<<8)))
  #define APPLY(P0,P1,tt) do{ if constexpr(MODE==1){ unsigned long long w_=*(const __attribute__((address_space(3))) unsigned long long*)(shm3+LDS_GK+wid*512+(((tt)&1)<<8)+r32*8); \
      w_=((tt)<=((q0+qrel)>>6))?w_:0ull; w_>>=(4*hi); const unsigned ml_=(unsigned)w_, mh_=(unsigned)(w_>>32); \
      _Pragma("unroll") for(int r=0;r<16;++r){ const int ps_=(r&3)+8*(r>>2); \
        P0[r]=__uint_as_float(__float_as_uint(P0[r])&(unsigned)__builtin_amdgcn_sbfe((int)ml_,ps_,1)); P1[r]=__uint_as_float(__float_as_uint(P1[r])&(unsigned)__builtin_amdgcn_sbfe((int)mh_,ps_,1)); } } }while(0)
  #define LOADBIAS(X0,X1,tt) do{ if constexpr(MODE==0){ const lds_f4p g_=(lds_f4p)(shm3+LDS_GK+16*hi)+(tt)*16; \
      _Pragma("unroll") for(int g4=0;g4<4;++g4){ const f32x4v a_=g_[2*g4], b_=g_[8+2*g4]; \
        _Pragma("unroll") for(int i_=0;i_<4;++i_){ X0[4*g4+i_]=a_[i_]; X1[4*g4+i_]=b_[i_]; } } } }while(0)
  #define CINIT(X) (*(MODE==0?&(X):&negm))
  typedef __attribute__((address_space(3))) const f32x4v* lds_f4p;
  const unsigned*msrc=nullptr; unsigned mdst=0u;
  if constexpr(MODE==1){ msrc=(const unsigned*)(MKT+(size_t)b*(SEQ/KVBLK)*SEQ+(q0+wid*QBLK+(lane>>1)))+(lane&1); mdst=lds0+LDS_GK+wid*512; MLOAD(0); }
  if constexpr(MODE==0){
    const float*src=GKg+(size_t)(b*NHEAD+h)*SEQ; const float ref=src[q0+QB-1];   __attribute__((address_space(3))) float*gk=(__attribute__((address_space(3))) float*)(shm3+LDS_GK);
    for(int i=tid*4;i<q0+QB-kt0*KVBLK;i+=NW*64*4){ f32x4v v=*(const f32x4v*)(src+kt0*KVBLK+i); v=v-ref; *(__attribute__((address_space(3))) f32x4v*)(gk+i)=v; }
  }
  DMA_K(0,0);DMA_V(0,0);DMA_K(1,SLOTB);
  bf16x8 qr[4];
  #pragma unroll
  for(int d0=0;d0<4;++d0)qr[d0]=*reinterpret_cast<const bf16x8*>(&Qw[(long)r32*DM+d0*16+hi*8]);
  float mhat=0.f,l_reg=0.f;f32x16 o[2];o[0]=f32x16{};o[1]=f32x16{};f32x16 negm=f32x16{};if constexpr(MODE!=0){asm volatile("":"+v"(negm));}
  #define CMASK(P0,P1,t) do{ if constexpr(MODE==0){ int jb_=(t)-(NT-4); if(jb_>=0)cmask(P0,P1,jb_,qrel,hi);} }while(0)
  bool resc=false; bool mflag=false; constexpr int THR0=64;
  if constexpr(MODE==0){
    const float*gs_=GKg+(size_t)(b*NHEAD+h)*SEQ; const float span=gs_[q0+QB-1]-gs_[q0];
    if(__builtin_amdgcn_readfirstlane(span>100.f?1:0)){ mflag=true; mhat=-(gs_[q0+QB-1]-gs_[q0+wid*QBLK+QBLK-1]); } }
  #define START(P0,P1) do{ resc=false; if constexpr(MODE==0&&!FOX_GUARD){} else { const float rm=rowmax(P0,P1); \
    if constexpr(MODE==0){ if(__builtin_expect(__any(rm>(float)THR0),0)){ mhat+=__builtin_fmaxf(rm,0.f); mflag=true; } \
      if(mflag){ _Pragma("unroll") for(int r=0;r<16;++r){P0[r]=fsub_s(P0[r],mhat);P1[r]=fsub_s(P1[r],mhat);} } } \
    else { const float dl=rm; mhat=fadd_s(mhat,dl); \
      _Pragma("unroll") for(int r=0;r<16;++r){P0[r]=fsub_s(P0[r],dl);P1[r]=fsub_s(P1[r],dl);} \
      _Pragma("unroll") for(int r=0;r<16;++r)negm[r]=-mhat; asm volatile("":"+v"(negm)); } } \
    _Pragma("unroll") for(int r=0;r<16;++r)P0[r]=__builtin_amdgcn_exp2f(P0[r]); }while(0)
  #define RESC() do{ if(resc){ asm volatile("s_waitcnt lgkmcnt(0)":::"memory"); \
      _Pragma("unroll") for(int d_=0;d_<2;++d_) _Pragma("unroll") for(int r=0;r<16;++r)o[d_][r]*=wsf[crow(r,hi)]; } }while(0)
  f32x16 pA0,pA1,pB0,pB1;
  int sl_prev=0,sl_cur=0,sl_next=SLOTB;
  #define ROT() do{sl_prev=sl_cur;sl_cur=sl_next;sl_next=(sl_next==(NSLOT-1)*SLOTB)?0:sl_next+SLOTB;}while(0)
  DMA_K(2,2*SLOTB);
  WAIT_BAR(3);
  LOADBIAS(pA0,pA1,0); qkt<MODE==0>(pA0,pA1,Kbase,qr,negm,r32,hi);asm volatile("s_nop 15\n\ts_nop 7":"+v"(pA0),"+v"(pA1));CMASK(pA0,pA1,0);
  START(pA0,pA1);
  _Pragma("unroll") for(int r=0;r<16;++r)pA1[r]=__builtin_amdgcn_exp2f(pA1[r]);
  LOADBIAS(pB0,pB1,1);
  WAIT_BAR(0);
  DMA_K(3,0);DMA_V(1,SLOTB);
  ROT();
  kload8(kf,kp0+sl_cur);
  WAIT_BAR(2);
  s16x4 vlo[8],vhi[8]; u32x4 pw0,pw1,pw2,pw3;
  #define PKW(P,B) cvtpk_s(P[B],P[B+1])
  #define PAF(k) __builtin_bit_cast(bf16x8,pw##k)
  #define VFR(i) (bf16x8){vlo[i][0],vlo[i][1],vlo[i][2],vlo[i][3],vhi[i][0],vhi[i][1],vhi[i][2],vhi[i][3]}
  #define PIN(x) asm volatile("":"+v"(x))
  #define MX3(a,b,c) __builtin_fmaxf(__builtin_fmaxf((a),(b)),(c))
  #define GAPA(MF,A0,A1,A2,A3,W0,W1,PW) do{ MF; sacc+=A0; sacc+=A1; sacc+=A2; sacc+=A3; PIN(sacc); W0; W1; PIN(PW); SBAR(); }while(0)
  #define EX(v) __builtin_amdgcn_exp2f(v)
  #define GAPB(MF,X,B) do{ MF; X[B]=EX(X[B]); X[B+1]=EX(X[B+1]); X[B+2]=EX(X[B+2]); X[B+3]=EX(X[B+3]); PIN(X); SBAR(); }while(0)
  #define VRD(i) do{ vlo[i]=vtr(vp_+(((i)>>2)*4096+((i)&3)*1024)); vhi[i]=vtr(vp_+(((i)>>2)*4096+((i)&3)*1024+512)); }while(0)
  #define KRD(G,j) do{ if(G){ kload2(kf,kp0+sl_next,j); SBAR(); } }while(0)
  #define STEP(C0,C1,P0,P1,t,GK,GV,GL) do{ SBAR(); if constexpr(MODE==1){ APPLY(P0,P1,(t)-1); MLOAD(t); SBAR(); } \
    const lds_cptr vp_=vp0+sl_prev; \
    VRD(0); SBAR(); float sacc=(P0[0]+P0[1]); \
    GAPA(C0=__builtin_amdgcn_mfma_f32_32x32x16_bf16(kf[0],qr[0],CINIT(C0),0,0,0), P0[2],P0[3],P0[4],P0[5],     pw0[0]=PKW(P0,0), pw0[1]=PKW(P0,2), pw0); \
    VRD(4); SBAR(); GAPA(C1=__builtin_amdgcn_mfma_f32_32x32x16_bf16(kf[1],qr[0],CINIT(C1),0,0,0), P0[6],P0[7],P0[8],P0[9],     pw0[2]=PKW(P0,4), pw0[3]=PKW(P0,6), pw0); \
    VRD(1); SBAR(); GAPA(C0=__builtin_amdgcn_mfma_f32_32x32x16_bf16(kf[2],qr[1],C0,0,0,0),   P0[10],P0[11],P0[12],P0[13], pw1[0]=PKW(P0,8), pw1[1]=PKW(P0,10), pw1); \
    VRD(5); SBAR(); GAPA(C1=__builtin_amdgcn_mfma_f32_32x32x16_bf16(kf[3],qr[1],C1,0,0,0),   P0[14],P0[15],P1[0],P1[1],   pw1[2]=PKW(P0,12),pw1[3]=PKW(P0,14), pw1); \
    VRD(2); SBAR(); GAPA(C0=__builtin_amdgcn_mfma_f32_32x32x16_bf16(kf[4],qr[2],C0,0,0,0),   P1[2],P1[3],P1[4],P1[5],     pw2[0]=PKW(P1,0), pw2[1]=PKW(P1,2), pw2); \
    VRD(6); SBAR(); GAPA(C1=__builtin_amdgcn_mfma_f32_32x32x16_bf16(kf[5],qr[2],C1,0,0,0),   P1[6],P1[7],P1[8],P1[9],     pw2[2]=PKW(P1,4), pw2[3]=PKW(P1,6), pw2); \
    VRD(3); SBAR(); GAPA(C0=__builtin_amdgcn_mfma_f32_32x32x16_bf16(kf[6],qr[3],C0,0,0,0),   P1[10],P1[11],P1[12],P1[13], pw3[0]=PKW(P1,8), pw3[1]=PKW(P1,10), pw3); \
    VRD(7); SBAR(); GAPA(C1=__builtin_amdgcn_mfma_f32_32x32x16_bf16(kf[7],qr[3],C1,0,0,0),   P1[14],P1[15],0.f,0.f,       pw3[2]=PKW(P1,12),pw3[3]=PKW(P1,14), pw3); \
    l_reg+=sacc; if constexpr(MODE==0){ if((t)+1<NT){ LOADBIAS(P0,P1,(t)+1); } } \
    if(GK){DMA_K((t)+3,sl_cur);} if(GV){DMA_V((t)+1,sl_next);} \
    CMASK(C0,C1,t); \
    if constexpr(MODE==0&&!FOX_GUARD){ resc=false; asm volatile("":"+v"(C0),"+v"(C1)); } else \
    { float a=MX3(C0[0],C0[1],C1[0]),b=MX3(C0[2],C0[3],C1[1]); a=MX3(a,C1[2],C1[3]); \
      _Pragma("unroll") for(int r=4;r<16;r+=4){a=MX3(a,C0[r],C0[r+1]);b=MX3(b,C0[r+2],C0[r+3]);a=MX3(a,C1[r],C1[r+1]);b=MX3(b,C1[r+2],C1[r+3]);} \
      float rm=__builtin_fmaxf(a,b); { auto rr=__builtin_amdgcn_permlane32_swap(__float_as_uint(rm),__float_as_uint(rm),false,false); rm=__builtin_fmaxf(__uint_as_float(rr[0]),__uint_as_float(rr[1])); } \
      resc=false; \
      if constexpr(MODE==0){ rm-=mhat; \
        if(__builtin_expect(__any(rm>(float)THR0),0)){ const float dl=__builtin_fmaxf(rm,0.f); mhat+=dl; mflag=true; \
          const float f=__builtin_amdgcn_exp2f(-dl); l_reg*=f; if(hi==0)wsf[r32]=f; resc=true; } \
        if(mflag){ _Pragma("unroll") for(int r=0;r<16;++r){C0[r]-=mhat;C1[r]-=mhat;} } } \
      else if(__builtin_expect(__any(rm>(float)THRL),0)){ const float dl=__builtin_fmaxf(rm,0.f); mhat+=dl; \
        _Pragma("unroll") for(int r=0;r<16;++r){C0[r]-=dl;C1[r]-=dl;} \
        _Pragma("unroll") for(int r=0;r<16;++r)negm[r]=-mhat; asm volatile("":"+v"(negm)); \
        const float f=__builtin_amdgcn_exp2f(-dl); l_reg*=f; if(hi==0)wsf[r32]=f; resc=true; } } \
    SBAR(); \
    GAPB(o[0]=__builtin_amdgcn_mfma_f32_32x32x16_bf16(PAF(0),VFR(0),o[0],0,0,0), C0,0); \
    GAPB(o[1]=__builtin_amdgcn_mfma_f32_32x32x16_bf16(PAF(0),VFR(4),o[1],0,0,0), C0,4); \
    KRD(GL,0); GAPB(o[0]=__builtin_amdgcn_mfma_f32_32x32x16_bf16(PAF(1),VFR(1),o[0],0,0,0), C0,8); \
    KRD(GL,1); GAPB(o[1]=__builtin_amdgcn_mfma_f32_32x32x16_bf16(PAF(1),VFR(5),o[1],0,0,0), C0,12); \
    KRD(GL,2); GAPB(o[0]=__builtin_amdgcn_mfma_f32_32x32x16_bf16(PAF(2),VFR(2),o[0],0,0,0), C1,0); \
    KRD(GL,3); GAPB(o[1]=__builtin_amdgcn_mfma_f32_32x32x16_bf16(PAF(2),VFR(6),o[1],0,0,0), C1,4); \
    GAPB(o[0]=__builtin_amdgcn_mfma_f32_32x32x16_bf16(PAF(3),VFR(3),o[0],0,0,0), C1,8); \
    GAPB(o[1]=__builtin_amdgcn_mfma_f32_32x32x16_bf16(PAF(3),VFR(7),o[1],0,0,0), C1,12); \
    }while(0)
  int t=1;
  #undef CMASK
  #define CMASK(P0,P1,t) do{}while(0)
  for(;t+5<NT;t+=2){
    STEP(pB0,pB1,pA0,pA1,t,true,true,true);     WAIT_BAR(2); RESC(); ROT();
    STEP(pA0,pA1,pB0,pB1,t+1,true,true,true);   WAIT_BAR(2); RESC(); ROT();
  }
  #undef CMASK
  #define CMASK(P0,P1,t) do{ if constexpr(MODE==0){ int jb_=(t)-(NT-4); if(jb_>=0)cmask(P0,P1,jb_,qrel,hi);} }while(0)
  #define ENDW(tt) do{ if((tt)+3<NT){WAIT_BAR(2);} else if((tt)+2<NT){WAIT_BAR(1);} else {WAIT_BAR(0);} }while(0)
  for(;t+1<NT;t+=2){
    STEP(pB0,pB1,pA0,pA1,t,(t+3<NT),(t+1<NT),(t+1<NT));       ENDW(t);   RESC(); ROT();
    STEP(pA0,pA1,pB0,pB1,t+1,(t+4<NT),(t+2<NT),(t+2<NT));     ENDW(t+1); RESC(); ROT();
  }
  STEP(pB0,pB1,pA0,pA1,NT-1,false,false,false); RESC();
  if constexpr(MODE==1){ asm volatile("s_waitcnt vmcnt(0)":::"memory"); APPLY(pB0,pB1,NT-1); }
  { float sacc=pB0[0]+pB0[1]; _Pragma("unroll") for(int r=2;r<16;++r)sacc+=pB0[r]; _Pragma("unroll") for(int r=0;r<16;++r)sacc+=pB1[r]; l_reg+=sacc;
    pw0=(u32x4){PKW(pB0,0),PKW(pB0,2),PKW(pB0,4),PKW(pB0,6)};pw1=(u32x4){PKW(pB0,8),PKW(pB0,10),PKW(pB0,12),PKW(pB0,14)};pw2=(u32x4){PKW(pB1,0),PKW(pB1,2),PKW(pB1,4),PKW(pB1,6)};pw3=(u32x4){PKW(pB1,8),PKW(pB1,10),PKW(pB1,12),PKW(pB1,14)};
    SBAR(); pv(o,vb0+sl_cur,PAF(0),PAF(1),PAF(2),PAF(3)); }
  #undef PKW
  #undef PAF
  #undef VFR
  #undef PIN
  #undef MX3
  #undef GAPA
  #undef GAPB
  #undef EX
  #undef VRD
  #undef KRD
  #undef STEP
  #undef ENDW
  {auto rr=__builtin_amdgcn_permlane32_swap(__float_as_uint(l_reg),__float_as_uint(l_reg),false,false);l_reg=__uint_as_float(rr[0])+__uint_as_float(rr[1]);}
  if(hi==0)wsf[32+r32]=l_reg;asm volatile("s_waitcnt lgkmcnt(0)":::"memory");
  float rli[16];
  #pragma unroll
  for(int r=0;r<16;++r)rli[r]=__builtin_amdgcn_rcpf(wsf[32+crow(r,hi)]);
  unsigned char*Ow=(unsigned char*)O+(rowbase+q0+wid*QBLK)*DM+h*D;
  { __attribute__((address_space(3))) unsigned char*stg=(__attribute__((address_space(3))) unsigned char*)(shm3+LDS_OST)+wid*2048;
    #pragma unroll
    for(int r=0;r<16;++r){const int orow=crow(r,hi); const int w2=__builtin_amdgcn_cvt_pk_fp8_f32(o[0][r]*rli[r],o[1][r]*rli[r],0,false);
      stg[orow*64+r32]=(unsigned char)(w2&0xff); stg[orow*64+32+r32]=(unsigned char)((w2>>8)&0xff);}
    asm volatile("s_waitcnt lgkmcnt(0)":::"memory");
    #pragma unroll
    for(int i=0;i<2;++i){const int row=i*16+(lane>>2),ch=lane&3; const u32x4 v=*(const __attribute__((address_space(3))) u32x4*)(stg+row*64+ch*16); ATTN_STORE16(Ow+(long)row*DM+ch*16,v);} }
  asm volatile("s_waitcnt lgkmcnt(0)\n\ts_barrier":::"memory");
  #undef DMA_K
  #undef MLOAD
  #undef APPLY
  #undef LOADBIAS
  #undef CINIT
  #undef DMA_V
  #undef CMASK
  #undef START
  #undef RESC
  #undef ROT
}
constexpr int ATTN_LDS_BYTES=LDS_BYTES;
struct AttnTensors { const bf16* Q; const bf16* K; const bf16* V; bf16* O; const float* GK; const unsigned long long* MK; };
struct AttnUnit { int bh; int qb; };
struct StaticOrder {
  int vcu;
  __device__ __forceinline__ explicit StaticOrder(int grid,int block):vcu((block%8)*(grid/8)+block/8){}
  __device__ __forceinline__ bool next(int i,AttnUnit&u)const{ if(i>=4)return false; const int s=vcu&7; u.bh=vcu>>3; u.qb=(i==0)?s:(i==1)?15-s:(i==2)?16+s:31-s; return true; }
  __device__ __forceinline__ void a_ready(const AttnUnit&)const{}
  __device__ __forceinline__ void done(const AttnUnit&)const{}
};
template<int MODE,class Sched,int THRL=8> __device__ __forceinline__ void attn_phase(char*lds,const AttnTensors&T,const Sched&S,const int wv){
  AttnUnit u;
  for(int i=0;S.next(i,u);++i){ S.a_ready(u); attn_unit<MODE,THRL>(u.bh/NHEAD,u.bh%NHEAD,u.qb,T.Q,T.K,T.V,T.O,lds,T.GK,T.MK,wv); S.done(u); }
}
template<int MODE,int THRL=8> __device__ __forceinline__ void attn_phase_queue(char*lds,const AttnTensors&T,unsigned*head,volatile __attribute__((address_space(3))) unsigned*slot,const int wv,const bool tid0){
  constexpr int NUNITS=BATCH*NHEAD*NQB;
  for(;;){
    if(tid0){ *slot=__hip_atomic_fetch_add(head,1u,__ATOMIC_RELAXED,__HIP_MEMORY_SCOPE_AGENT); }
    asm volatile("s_waitcnt vmcnt(0) lgkmcnt(0)\n\ts_barrier":::"memory");
    const int idx=__builtin_amdgcn_readfirstlane((int)*slot);
    if(idx>=NUNITS)break;
    const int qb=NQB-1-idx/(BATCH*NHEAD), bh=idx%(BATCH*NHEAD);
    attn_unit<MODE,THRL>(bh/NHEAD,bh%NHEAD,qb,T.Q,T.K,T.V,T.O,lds,T.GK,T.MK,wv);
  }
}
#undef SBAR
#undef WAIT_BAR
}
#define GAS __attribute__((address_space(1)))
#define LAS __attribute__((address_space(3)))
__device__ __forceinline__ int lane_id_v() { int l; asm volatile("v_mbcnt_lo_u32_b32 %0, -1, 0\n\tv_mbcnt_hi_u32_b32 %0, -1, %0" : "=v"(l)); return l; }
typedef unsigned short bf16;
typedef unsigned v4u __attribute__((ext_vector_type(4)));
typedef float f32x4 __attribute__((ext_vector_type(4)));
typedef short bf16x8 __attribute__((ext_vector_type(8)));
typedef GAS unsigned gu32;
typedef GAS unsigned long long gu64;
#define RLX_AGENT __ATOMIC_RELAXED, __HIP_MEMORY_SCOPE_AGENT
#define LDS_WAIT() asm volatile("s_waitcnt lgkmcnt(0)" ::: "memory")
#define VM_WAIT() asm volatile("s_waitcnt vmcnt(0)" ::: "memory")
__device__ __forceinline__ unsigned long long rt() { return __builtin_amdgcn_s_memrealtime(); }
__device__ __forceinline__ unsigned f2bf(float f) { unsigned u = __builtin_bit_cast(unsigned, f); return (u + 0x7fffu + ((u >> 16) & 1u)) >> 16; }
__device__ __forceinline__ unsigned pk2(float lo, float hi) { return f2bf(lo) | (f2bf(hi) << 16); }

#define XB_TMO      128
#define XB_XCNT(j)  (256  + 64 * (j))
#define XB_XSUB(j)  (1280 + 64 * (j))
#define XB_XGEN(j)  (2304 + 64 * (j))
#define XB_TOP      3328
#define XB_TOPGEN   3392
#define XCD_BAR_WORDS 3456
#define XB_SPIN_CAP (1u << 18)

__device__ __forceinline__ unsigned xb_ld(unsigned* p)              { return __hip_atomic_load(p, __ATOMIC_RELAXED, __HIP_MEMORY_SCOPE_AGENT); }
__device__ __forceinline__ unsigned xb_add(unsigned* p, unsigned v) { return __hip_atomic_fetch_add(p, v, __ATOMIC_RELAXED, __HIP_MEMORY_SCOPE_AGENT); }
__device__ __forceinline__ unsigned xb_xcc_id() { return (unsigned)__builtin_amdgcn_s_getreg((3 << 11) | 20) & 0xFu; }
#define XB_SPIN(cond, bar) do { unsigned _sp = 0; while (cond) { __builtin_amdgcn_s_sleep(1); \
    if ((++_sp & 255u) == 0u) { if (xb_ld(&(bar)[XB_TMO])) break; if (_sp > XB_SPIN_CAP) { atomicAdd(&(bar)[XB_TMO], 1u); break; } } } } while (0)

struct XcdBarrier {
    unsigned* bar; unsigned x;
    volatile LAS unsigned* st;
};

__device__ __forceinline__ XcdBarrier xcd_barrier_post(unsigned* bar, volatile LAS unsigned* st, bool tid0) {
    XcdBarrier b; b.bar = bar; b.x = xb_xcc_id(); b.st = st;
    if (tid0) (void)xb_add(&bar[XB_XCNT(b.x)], 1u);
    return b;
}
__device__ __forceinline__ void xcd_barrier_complete(unsigned* bar, unsigned x, unsigned& nloc, unsigned& nx) {
    const unsigned G = gridDim.x * gridDim.y * gridDim.z;
    unsigned sum, cnt, mine, sp = 0u;
    for (;;) {
        sum = 0u; cnt = 0u; mine = 0u;
#pragma unroll
        for (unsigned j = 0; j < 16; ++j) { const unsigned c = xb_ld(&bar[XB_XCNT(j)]); sum += c; cnt += (c > 0u) ? 1u : 0u; mine = (j == x) ? c : mine; }
        if (sum == G) break;
        __builtin_amdgcn_s_sleep(1);
        if ((++sp & 255u) == 0u) { if (xb_ld(&bar[XB_TMO])) break; if (sp > XB_SPIN_CAP) { atomicAdd(&bar[XB_TMO], 1u); break; } }
    }
    nloc = mine > 0u ? mine : 1u; nx = cnt > 0u ? cnt : 1u;
}

__device__ __forceinline__ void xcd_barrier(const XcdBarrier& b, bool tid0) {
    asm volatile("s_waitcnt vmcnt(0)" ::: "memory");
    __syncthreads();
    if (tid0) {
        unsigned* bar = b.bar;
        __builtin_amdgcn_s_waitcnt(0);
        unsigned nloc = b.st[0], nx = b.st[1];
        if (nloc == 0u) { xcd_barrier_complete(bar, b.x, nloc, nx); b.st[0] = nloc; b.st[1] = nx; }
        const unsigned old = xb_add(&bar[XB_XSUB(b.x)], 1u);
        const unsigned gen = old / nloc;
        if (old + 1u == (gen + 1u) * nloc) {
            __builtin_amdgcn_fence(__ATOMIC_RELEASE, "agent");
            asm volatile("s_waitcnt vmcnt(0)" ::: "memory");
            const unsigned og = xb_add(&bar[XB_TOP], 1u);
            const unsigned tg = og / nx;
            if (og + 1u == (tg + 1u) * nx) xb_add(&bar[XB_TOPGEN], 1u);
            else XB_SPIN(xb_ld(&bar[XB_TOPGEN]) == tg, bar);
            __builtin_amdgcn_fence(__ATOMIC_ACQUIRE, "agent");
            xb_add(&bar[XB_XGEN(b.x)], 1u);
            asm volatile("s_waitcnt vmcnt(0)" ::: "memory");
        } else {
            XB_SPIN(xb_ld(&bar[XB_XGEN(b.x)]) == gen, bar);
            __builtin_amdgcn_fence(__ATOMIC_ACQUIRE, "agent");
            asm volatile("s_waitcnt vmcnt(0)" ::: "memory");
        }
    }
    __syncthreads();
}
constexpr int NWAVES = 8;
#ifndef MK_ONE_LAUNCH
#define MK_ONE_LAUNCH 1
#endif
constexpr int BATCH = 2, SEQ = 8192, D = 1024, M = BATCH * SEQ, NH = 16, HD = 64, IDXH = 8, IDXD = 64, DFF = 2816, NEXP = 8, KSEL = 256;
constexpr int AIN_N = 3 * D + IDXH * IDXD + IDXD + IDXH;
constexpr int AIN_NP = 3840;
constexpr int KVQ_NP = 3328;
constexpr int SORT_ROWS = 2 * M + NEXP * 256;
constexpr float C2 = 0.125f * 1.4426950408889634f;
constexpr float LOG2E = 1.4426950408889634f;
constexpr size_t MiB = 1u << 20;
constexpr size_t WS_CTL = 0, CTL_ZERO_BYTES = 96 * 1024;
constexpr size_t WS_COS = 1 * MiB, WS_SIN = 2 * MiB;
constexpr size_t WS_SSQ = 3 * MiB;
constexpr size_t WS_WI = 4 * MiB;
constexpr size_t WS_LOGF = 5 * MiB;
constexpr size_t WS_GK = 6 * MiB;
constexpr size_t WS_TOK = 7 * MiB;
constexpr size_t WS_RSD = 8 * MiB;
constexpr size_t WS_GATE = 9 * MiB;
constexpr size_t WS_KI = 10 * MiB;
constexpr size_t WS_W = 16 * MiB;
constexpr size_t W_AIN = WS_W, W_AIN_SZ = (size_t)AIN_NP * D * 2;
constexpr size_t W_AOUT = W_AIN + 2 * W_AIN_SZ, W_SQ_SZ = (size_t)D * D * 2;
constexpr size_t W_KVQ = W_AOUT + 2 * W_SQ_SZ, W_KVQ_SZ = (size_t)KVQ_NP * D * 2;
constexpr size_t W_BQ3 = W_KVQ + W_KVQ_SZ;
constexpr size_t W_BOUT = W_BQ3 + W_SQ_SZ;
constexpr size_t W_DGU = W_BOUT + 2 * W_SQ_SZ, W_GU_SZ = (size_t)2 * DFF * D * 2;
constexpr size_t W_DDN = W_DGU + 2 * W_GU_SZ, W_DN_SZ = (size_t)D * DFF * 2;
constexpr size_t W_MGU = W_DDN + 2 * W_DN_SZ;
constexpr size_t W_MDN = W_MGU + 16 * W_GU_SZ;
constexpr size_t W_END = W_MDN + 16 * W_DN_SZ;
constexpr size_t W_GU8_SZ = (size_t)2 * DFF * D, W_DN8_SZ = (size_t)D * DFF;
constexpr size_t W_AIN8_SZ = (size_t)AIN_NP * D, W_SQ8_SZ = (size_t)D * D;
constexpr size_t W_AINX_OFF = (size_t)3 * D * D;
constexpr float GU_PRESCALE = 64.0f, DN_PRESCALE = 256.0f, IN_PRESCALE = 64.0f, OUT_PRESCALE = 128.0f;
static_assert(W_END <= 352 * MiB, "weights region");
constexpr size_t WS_HB = 352 * MiB;
constexpr size_t WS_Q = 384 * MiB, WS_K = 416 * MiB, WS_V = 448 * MiB;
constexpr size_t WS_QI = 480 * MiB;
constexpr size_t WS_MASK = 496 * MiB;
constexpr size_t WS_SC = 512 * MiB;
constexpr size_t WS_ACT = 768 * MiB;
constexpr size_t WS_ASORT = 960 * MiB;
constexpr size_t WS_Y = 1028 * MiB;
constexpr size_t WS_O = 1100 * MiB;
constexpr size_t WS_H2 = 1132 * MiB;
constexpr size_t WS_HB8 = 1196 * MiB;
constexpr size_t WS_END = 1212 * MiB;
static_assert(WS_ACT + (size_t)SORT_ROWS * DFF * 2 <= WS_ASORT && WS_ASORT + (size_t)SORT_ROWS * D * 2 <= WS_Y && WS_Y + (size_t)SORT_ROWS * D * 2 <= WS_END, "ws map");
constexpr int CW_BAR = 4096;
constexpr int CW_AQ = 16384 + 256;
constexpr int CW_CNT = 16384;
constexpr int RING_OFF = 0, RING_BYTES = 131072;
constexpr int LDSCTL_OFF = RING_BYTES, MISC_OFF = LDSCTL_OFF + 320;
constexpr int LDS_BYTES = 163840;

typedef unsigned short bf16;
typedef unsigned v4u __attribute__((ext_vector_type(4)));
typedef unsigned v2u __attribute__((ext_vector_type(2)));
using pg8::pkbf;

struct Frame {
    LAS unsigned char* lds;
    volatile LAS unsigned* MISC;
    gu32* ctl;
    int tid, lane, wave, vcu, G, dry;
    unsigned char* ws;
};
__device__ __forceinline__ float wave_sum(float v) {
#pragma unroll
    for (int o = 1; o < 64; o <<= 1) v += __shfl_xor(v, o);
    return v;
}
__device__ __forceinline__ float bf2f(unsigned short b) { return __uint_as_float((unsigned)b << 16); }

__device__ __forceinline__ int map_col(int map, int n) {
    if (map == 1) { const bool plain = (n >= 2048 && n < 3072) || n >= 3648; if (plain) return n; const int d = n & 63; return (n & ~63) + 8 * ((d & 31) >> 2) + (d & 3) + 4 * (d >> 5); }
    if (map == 3) { if (n >= 576) return n; const int d = n & 63; return (n & ~63) + 8 * ((d & 31) >> 2) + (d & 3) + 4 * (d >> 5); }
    if (map == 2) { const int j = n < DFF ? n : n - DFF; return 8 * (j >> 2) + (j & 3) + (n < DFF ? 0 : 4); }
    return n;
}
template <bool F8> __device__ __forceinline__ void conv_item(const float* W, int K, int N, int ncols, void* WTv, const float* gain, float wmul, int map, int row_off, int col_off, int item, int lane) {
    const int nblk = (ncols + 63) / 64, kb = item / nblk, nb = item % nblk, k0 = 64 * kb + 16 * (lane >> 4), n0 = 64 * nb + 4 * (lane & 15);
    if (n0 >= ncols) return;
    const GAS f32x4* src = (const GAS f32x4*)(W + (size_t)k0 * N + col_off + n0);
    f32x4 v[16];
#pragma unroll
    for (int i = 0; i < 16; ++i) v[i] = __builtin_nontemporal_load(src + (size_t)i * (N / 4));
#pragma unroll
    for (int q = 0; q < 4; ++q) { f32x4 g = (f32x4){wmul, wmul, wmul, wmul}; if (gain) g = g * *(const GAS f32x4*)(gain + k0 + 4 * q);
#pragma unroll
        for (int c = 0; c < 4; ++c) v[4 * q + c] = v[4 * q + c] * g[c]; }
#pragma unroll
    for (int j = 0; j < 4; ++j) {
        const size_t drow = (size_t)(row_off + map_col(map, n0 + j));
        if constexpr (F8) { v4u o; o.x = pg8::pk4f8(v[0][j], v[1][j], v[2][j], v[3][j]); o.y = pg8::pk4f8(v[4][j], v[5][j], v[6][j], v[7][j]); o.z = pg8::pk4f8(v[8][j], v[9][j], v[10][j], v[11][j]); o.w = pg8::pk4f8(v[12][j], v[13][j], v[14][j], v[15][j]);
            *(GAS v4u*)((unsigned char*)WTv + drow * K + k0) = o; }
        else { GAS v4u* dst = (GAS v4u*)((bf16*)WTv + drow * K + k0); v4u o0, o1;
            o0.x = pkbf(v[0][j], v[1][j]); o0.y = pkbf(v[2][j], v[3][j]); o0.z = pkbf(v[4][j], v[5][j]); o0.w = pkbf(v[6][j], v[7][j]);
            o1.x = pkbf(v[8][j], v[9][j]); o1.y = pkbf(v[10][j], v[11][j]); o1.z = pkbf(v[12][j], v[13][j]); o1.w = pkbf(v[14][j], v[15][j]);
            dst[0] = o0; dst[1] = o1; }
    }
}
__device__ const float INVF_TAB[32] = {1.000000000e+00f, 7.498942018e-01f, 5.623413324e-01f, 4.216965139e-01f, 3.162277639e-01f, 2.371373773e-01f, 1.778279394e-01f, 1.333521456e-01f, 1.000000015e-01f, 7.498942316e-02f, 5.623413250e-02f, 4.216964915e-02f, 3.162277490e-02f, 2.371373773e-02f, 1.778279431e-02f, 1.333521400e-02f, 9.999999776e-03f, 7.498942316e-03f, 5.623413250e-03f, 4.216964822e-03f, 3.162277630e-03f, 2.371373819e-03f, 1.778279431e-03f, 1.333521446e-03f, 1.000000047e-03f, 7.498941850e-04f, 5.623413017e-04f, 4.216965172e-04f, 3.162277571e-04f, 2.371373703e-04f, 1.778279402e-04f, 1.333521504e-04f};
struct Args { const float* in[17]; float* out; unsigned char* ws; int ph_lo, ph_hi, li, pad; };
typedef const volatile __attribute__((address_space(4))) Args* KArgs;
enum { I_X = 0, I_ANORM, I_AWIN, I_AWOUT, I_KVNORM, I_WKV, I_BF, I_BNORM, I_BWQ, I_BWOUT, I_FFNNORM, I_DGU, I_DDN, I_ROUTER, I_MGU, I_MDN, I_FNORM };

struct KIn { KArgs ap; __device__ __forceinline__ const float* operator[](int i) const { return (const float*)ap->in[i]; } };
constexpr int IT_AINQ = (D / 64) * (3 * D / 64), IT_AINX = (D / 64) * ((AIN_N - 3 * D + 63) / 64), IT_AIN = IT_AINQ + IT_AINX;
constexpr int IT_SQ = (D / 64) * (D / 64);
constexpr int IT_KV = (D / 64) * (2 * D / 64);
constexpr int IT_KVF = (D / 64) * 1;
constexpr int IT_GU = (D / 64) * (2 * DFF / 64);
constexpr int IT_DN = (DFF / 64) * (D / 64);
constexpr int CV_SEG0 = IT_AIN;
constexpr int CV_SEG1 = CV_SEG0 + IT_SQ + IT_GU + IT_DN + IT_AIN + IT_SQ + 8 * IT_GU + 8 * IT_DN;
constexpr int CV_SEG2 = CV_SEG1 + IT_KV + IT_KVF + 2 * IT_SQ + 2 * IT_SQ + IT_GU + IT_DN + 8 * IT_GU + 8 * IT_DN;
__device__ __forceinline__ void conv_ain(const KIn& in, unsigned char* ws, int l, int r, int lane) {
    if (r < IT_AINQ) conv_item<true>(in[I_AWIN] + (size_t)l * D * AIN_N, D, AIN_N, 3 * D, ws + W_AIN + l * W_AIN_SZ, in[I_ANORM] + l * D, IN_PRESCALE, 1, 0, 0, r, lane);
    else conv_item<false>(in[I_AWIN] + (size_t)l * D * AIN_N, D, AIN_N, AIN_N - 3 * D, ws + W_AIN + l * W_AIN_SZ + W_AINX_OFF, in[I_ANORM] + l * D, 1.0f, 3, 0, 3 * D, r - IT_AINQ, lane);
}
__device__ __forceinline__ void conv_one(const KIn& in, unsigned char* ws, int r, int lane) {
    int job, p = 0;
    if (r < IT_AIN) job = 0;
    else if ((r -= IT_AIN) < IT_SQ) job = 1;
    else if ((r -= IT_SQ) < IT_GU) job = 2;
    else if ((r -= IT_GU) < IT_DN) job = 3;
    else if ((r -= IT_DN) < IT_AIN) { job = 0; p = 1; }
    else if ((r -= IT_AIN) < IT_SQ) { job = 1; p = 1; }
    else if ((r -= IT_SQ) < 8 * IT_GU) { job = 4; p = r / IT_GU; r -= p * IT_GU; }
    else if ((r -= 8 * IT_GU) < 8 * IT_DN) { job = 5; p = r / IT_DN; r -= p * IT_DN; }
    else if ((r -= 8 * IT_DN) < IT_KV) job = 6;
    else if ((r -= IT_KV) < IT_KVF) job = 7;
    else if ((r -= IT_KVF) < IT_SQ) job = 8;
    else if ((r -= IT_SQ) < IT_SQ) job = 9;
    else if ((r -= IT_SQ) < 2 * IT_SQ) { job = 10; p = r / IT_SQ; r -= p * IT_SQ; }
    else if ((r -= 2 * IT_SQ) < IT_GU) { job = 2; p = 1; }
    else if ((r -= IT_GU) < IT_DN) { job = 3; p = 1; }
    else if ((r -= IT_DN) < 8 * IT_GU) { job = 4; p = r / IT_GU; r -= p * IT_GU; p += 8; }
    else { r -= 8 * IT_GU; job = 5; p = r / IT_DN; r -= p * IT_DN; p += 8; }
    switch (job) {
    case 0: conv_ain(in, ws, p, r, lane); break;
    case 1: conv_item<true>(in[I_AWOUT] + (size_t)p * D * D, D, D, D, ws + W_AOUT + p * W_SQ_SZ, nullptr, OUT_PRESCALE, 0, 0, 0, r, lane); break;
    case 2: conv_item<true>(in[I_DGU] + (size_t)p * D * 2 * DFF, D, 2 * DFF, 2 * DFF, ws + W_DGU + p * W_GU8_SZ, in[I_FFNNORM] + (2 * p) * D, GU_PRESCALE, 2, 0, 0, r, lane); break;
    case 3: conv_item<true>(in[I_DDN] + (size_t)p * DFF * D, DFF, D, D, ws + W_DDN + p * W_DN8_SZ, nullptr, DN_PRESCALE, 0, 0, 0, r, lane); break;
    case 4: conv_item<true>(in[I_MGU] + (size_t)p * D * 2 * DFF, D, 2 * DFF, 2 * DFF, ws + W_MGU + (size_t)p * W_GU8_SZ, in[I_FFNNORM] + (2 * (p >> 3) + 1) * D, GU_PRESCALE, 2, 0, 0, r, lane); break;
    case 5: conv_item<true>(in[I_MDN] + (size_t)p * DFF * D, DFF, D, D, ws + W_MDN + (size_t)p * W_DN8_SZ, nullptr, DN_PRESCALE, 0, 0, 0, r, lane); break;
    case 6: conv_item<true>(in[I_WKV], D, 2 * D + NH, 2 * D, ws + W_KVQ, in[I_KVNORM], IN_PRESCALE, 0, D, 0, r, lane); break;
    case 7: conv_item<true>(in[I_WKV], D, 2 * D + NH, NH, ws + W_KVQ, in[I_KVNORM], IN_PRESCALE, 0, 3 * D, 2 * D, r, lane); break;
    case 8: conv_item<true>(in[I_BWQ], D, D, D, ws + W_KVQ, in[I_BNORM], IN_PRESCALE, 0, 0, 0, r, lane); break;
    case 9: conv_item<true>(in[I_BWQ] + (size_t)D * D, D, D, D, ws + W_BQ3, in[I_BNORM] + D, IN_PRESCALE, 0, 0, 0, r, lane); break;
    default: conv_item<true>(in[I_BWOUT] + (size_t)p * D * D, D, D, D, ws + W_BOUT + p * W_SQ_SZ, nullptr, OUT_PRESCALE, 0, 0, 0, r, lane); break;
    }
}
__device__ __forceinline__ void p0_prologue(Frame& F, KArgs ap) {
    struct { KIn in; } A{{ap}};
    const int gw = F.vcu * NWAVES + F.wave, NGW = F.G * NWAVES;
    unsigned char* ws = F.ws;
    for (int it = gw; it < CV_SEG0; it += NGW) conv_one(A.in, ws, it, F.lane);
    {
        constexpr int ZA = AIN_NP - AIN_N, ZK = KVQ_NP - (3 * D + NH), ZROWS = 2 * ZA + ZK;
        for (int zr = gw; zr < ZROWS; zr += NGW) {
            if (zr < 2 * ZA) { bf16* dst = (bf16*)(ws + W_AIN + (zr / ZA) * W_AIN_SZ + W_AINX_OFF) + (size_t)(AIN_N - 3 * D + zr % ZA) * D; ((GAS v4u*)dst)[F.lane] = (v4u){0u, 0u, 0u, 0u}; ((GAS v4u*)dst)[64 + F.lane] = (v4u){0u, 0u, 0u, 0u}; }
            else { unsigned char* dst = ws + W_KVQ + (size_t)(3 * D + NH + (zr - 2 * ZA)) * D; ((GAS v4u*)dst)[F.lane] = (v4u){0u, 0u, 0u, 0u}; }
        }
    }
    {
        float* cosT = (float*)(ws + WS_COS); float* sinT = (float*)(ws + WS_SIN);
        for (int idx = (F.vcu * NWAVES + F.wave) * 64 + F.lane; idx < SEQ * 32; idx += F.G * NWAVES * 64) {
            const int t = idx >> 5, i = idx & 31;
            const float ang = (float)t * INVF_TAB[i];
            const double rev = (double)ang * 0.15915494309189535; const float fr = (float)(rev - floor(rev));
            cosT[idx] = __builtin_amdgcn_cosf(fr); sinT[idx] = __builtin_amdgcn_sinf(fr);
        }
    }
    {
        const float* x = A.in[I_X]; bf16* HB = (bf16*)(ws + WS_HB); unsigned char* HB8 = ws + WS_HB8; float* ssq = (float*)(ws + WS_SSQ);
        for (int m = gw; m < M; m += NGW) {
            const GAS f32x4* xr = (const GAS f32x4*)(x + (size_t)m * D) + F.lane; float s = 0.f;
            GAS unsigned long long* o8 = (GAS unsigned long long*)(HB + (size_t)m * D) + F.lane; GAS unsigned* o4 = (GAS unsigned*)(HB8 + (size_t)m * D) + F.lane;
#pragma unroll
            for (int j = 0; j < 4; ++j) { const f32x4 v = xr[64 * j]; s += (v.x * v.x + v.y * v.y) + (v.z * v.z + v.w * v.w);
                o8[64 * j] = (unsigned long long)pkbf(v.x, v.y) | ((unsigned long long)pkbf(v.z, v.w) << 32); o4[64 * j] = pg8::pk4f8(v.x, v.y, v.z, v.w); }
            s = wave_sum(s);
            if (F.lane < 16) ssq[(size_t)m * 16 + F.lane] = F.lane == 0 ? s : 0.f;
        }
    }
}

typedef float f32x16 __attribute__((ext_vector_type(16)));
__device__ __forceinline__ void sc_glds16(const void* gsrc, unsigned lds_dst) { unsigned keep;
    asm volatile("s_mov_b32 %0, m0\n\ts_mov_b32 m0, %2\n\ts_nop 0\n\tglobal_load_lds_dwordx4 %1, off\n\ts_mov_b32 m0, %0" : "=&s"(keep) : "v"(gsrc), "s"(lds_dst) : "memory"); }
__device__ __forceinline__ float relu_s(float x) { const int i = __float_as_int(x); return __int_as_float(i > 0 ? i : 0); }
struct ScUnit { int b, j, kc, nt; };
__device__ __forceinline__ ScUnit sc_full(int f) {
    ScUnit q; q.b = f / 960; int r = f % 960; int g = 1;
    while (r >= 8 * g) { r -= 8 * g; ++g; }
    q.j = 8 * g + r / g; q.kc = r % g; q.nt = 8; return q;
}
__device__ __forceinline__ ScUnit sc_natural(int u) {
    constexpr int UPB = 1088; ScUnit q; q.b = u / UPB; int r = u % UPB; int g = 0;
    while (r >= 8 * (g + 1)) { r -= 8 * (g + 1); ++g; }
    q.j = 8 * g + r / (g + 1); q.kc = r % (g + 1);
    const int s_beg = 512 * q.kc, s_end = (512 * (q.kc + 1) < 64 * (q.j + 1)) ? 512 * (q.kc + 1) : 64 * (q.j + 1); q.nt = (s_end - s_beg) >> 6; return q;
}
__device__ __forceinline__ bool sc_unit(int c, int G, int i, ScUnit& q) {
    if (G != 256) { const int u = c + i * G; if (u >= 2176) return false; q = sc_natural(u); return true; }
    if (i < 7) { q = sc_full(c + 256 * i); return true; }
    if (c < 128) { if (i > 7) return false; q = sc_full(1792 + c); return true; }
    if (i > 8) return false;
    const int cc = c - 128, cls = cc >> 5, idx = cc & 31, rem = (i == 7) ? 7 - cls : cls;
    q.b = idx >> 4; q.j = 8 * (idx & 15) + rem; q.kc = q.j >> 3; q.nt = rem + 1; return true;
}
__device__ __forceinline__ void idx_scores_phase(Frame& F) {
    const bf16* QI = (const bf16*)(F.ws + WS_QI); const bf16* KI = (const bf16*)(F.ws + WS_KI); const float* WI = (const float*)(F.ws + WS_WI);
    _Float16* SC = (_Float16*)(F.ws + WS_SC);
    const int lane = F.lane, r32 = lane & 31, hi = lane >> 5, wave = F.wave;
    constexpr int KS_OFF = RING_OFF, TS_OFF = LDSCTL_OFF + 4096;
    const unsigned lds0 = (unsigned)(uintptr_t)(unsigned char*)F.lds;
    const LAS unsigned char* kfrag = F.lds + KS_OFF + hi * 1024 + r32 * 16;
    LAS _Float16* tsw = (LAS _Float16*)(F.lds + TS_OFF + wave * 2048) + hi * 64 + r32;
    const LAS v4u* tsr = (const LAS v4u*)(F.lds + TS_OFF + wave * 2048 + (lane >> 3) * 256 + (lane & 7) * 16);
#define SC_DMA(q, buf) do { const bf16* ks_ = KI + (size_t)((q).b * SEQ + 512 * (q).kc + lane) * 64 + wave * 8; \
        for (int t_ = 0; t_ < (q).nt; ++t_) sc_glds16(ks_ + (size_t)t_ * 64 * 64, (unsigned)__builtin_amdgcn_readfirstlane(lds0 + KS_OFF + (buf) * 65536 + t_ * 8192 + wave * 1024)); } while (0)
    int ui = 0, par = 0; ScUnit q, qn;
    bool have = sc_unit(F.vcu, F.G, 0, q);
    bf16x8 a[2][4]; f32x4 w[2][4];
#define SC_LOAD_AW(q) do { const int tk_ = (q).b * SEQ + 64 * (q).j + 8 * wave; \
        _Pragma("unroll") for (int rt = 0; rt < 2; ++rt) { \
            _Pragma("unroll") for (int ks = 0; ks < 4; ++ks) a[rt][ks] = *(const bf16x8*)(QI + (size_t)(tk_ + 4 * rt + (r32 >> 3)) * 512 + (r32 & 7) * 64 + ks * 16 + hi * 8); \
            _Pragma("unroll") for (int tl = 0; tl < 4; ++tl) w[rt][tl] = *(const f32x4*)(WI + (size_t)(tk_ + 4 * rt + tl) * 8 + 4 * hi); } } while (0)
    if (have) { SC_DMA(q, 0); SC_LOAD_AW(q); }
    asm volatile("s_waitcnt vmcnt(0)\n\ts_barrier" ::: "memory");
    while (have) {
        const bool hn = sc_unit(F.vcu, F.G, ui + 1, qn);
        const int tok0 = q.b * SEQ + 64 * q.j + 8 * wave;
        _Float16* dst = SC + (size_t)(tok0 + (lane >> 3)) * SEQ + 512 * q.kc + 8 * (lane & 7);
        const LAS unsigned char* kb = kfrag + par * 65536;
        for (int it = 0; it < q.nt; ++it) {
#pragma unroll
            for (int ct = 0; ct < 2; ++ct) {
                bf16x8 bk[4];
#pragma unroll
                for (int ks = 0; ks < 4; ++ks) bk[ks] = *(const LAS bf16x8*)(kb + it * 8192 + ks * 2048 + ct * 512);
#pragma unroll
                for (int rt = 0; rt < 2; ++rt) {
                    f32x16 d = {};
#pragma unroll
                    for (int ks = 0; ks < 4; ++ks) d = __builtin_amdgcn_mfma_f32_32x32x16_bf16(a[rt][ks], bk[ks], d, 0, 0, 0);
#pragma unroll
                    for (int tl = 0; tl < 4; ++tl) { float p = 0.f;
#pragma unroll
                        for (int jj = 0; jj < 4; ++jj) p += w[rt][tl][jj] * relu_s(d[4 * tl + jj]);
                        tsw[(4 * rt + tl) * 128 + 32 * ct] = (_Float16)p; }
                }
            }
            typedef _Float16 h8 __attribute__((ext_vector_type(8)));
            const h8 va = __builtin_bit_cast(h8, tsr[0]), vb = __builtin_bit_cast(h8, tsr[8]);
            const v4u val = __builtin_bit_cast(v4u, (h8)(va + vb));
            if (!(F.dry & 1)) *(GAS v4u*)(dst + it * 64) = val;
            if (it == 0 && hn) SC_DMA(qn, par ^ 1);
        }
        if (hn) SC_LOAD_AW(qn);
        asm volatile("s_waitcnt vmcnt(0) lgkmcnt(0)\n\ts_barrier" ::: "memory");
        ++ui; par ^= 1; q = qn; have = hn;
    }
#undef SC_DMA
#undef SC_LOAD_AW
}

__device__ __forceinline__ unsigned wave_total(unsigned cnt, int nbits) {
    unsigned tot = 0;
    for (int b = 0; b < nbits; ++b) tot += (unsigned)__builtin_popcountll(__ballot((cnt >> b) & 1u)) << b;
    return tot;
}
template <int NPK> __device__ __forceinline__ unsigned count_ge(const unsigned (&pk)[NPK], unsigned cand) {
    unsigned cnt = 0; const unsigned addc = (0x8000u - cand) * 0x00010001u;
#pragma unroll
    for (int i = 0; i < NPK; ++i) cnt += (unsigned)__builtin_popcount((pk[i] + addc) & 0x80008000u);
    return wave_total(cnt, 8);
}
template <int NPK, int R> __device__ __forceinline__ void select_rows(const unsigned short* const (&sc)[R], int n, int lane, unsigned char* const (&mbase)[R]  ) {
    unsigned pk[R][NPK];
#pragma unroll
    for (int c = 0; c < NPK / 4; ++c)
#pragma unroll
        for (int r = 0; r < R; ++r) {
            v4u v = (v4u){0xFC00FC00u, 0xFC00FC00u, 0xFC00FC00u, 0xFC00FC00u};
            if (512 * c + 8 * lane < n) v = *(const GAS v4u*)(sc[r] + 512 * c + 8 * lane);
            pk[r][4 * c + 0] = v.x; pk[r][4 * c + 1] = v.y; pk[r][4 * c + 2] = v.z; pk[r][4 * c + 3] = v.w;
        }
    bool hipos[R];
#pragma unroll
    for (int r = 0; r < R; ++r) { unsigned cpos = 0;
#pragma unroll
        for (int i = 0; i < NPK; ++i) { const unsigned m = pk[r][i] & 0x7FFF7FFFu; cpos += (unsigned)__builtin_popcount((m + 0x7FFF7FFFu) & ~pk[r][i] & 0x80008000u); }
        hipos[r] = wave_total(cpos, 8) >= (unsigned)KSEL; }
#pragma unroll
    for (int r = 0; r < R; ++r)
#pragma unroll
        for (int c = 0; c < NPK / 4; ++c) { const bool valid = 512 * c + 8 * lane < n;
#pragma unroll
            for (int q = 0; q < 4; ++q) { const unsigned x = pk[r][4 * c + q], m = x & 0x7FFF7FFFu; const unsigned pos = ((m + 0x7FFF7FFFu) & ~x & 0x80008000u) >> 15, fill = pos * 0x7FFFu;
                const unsigned k = hipos[r] ? (m & fill) : ((0x7FFE7FFEu - m) | fill);
                pk[r][4 * c + q] = valid ? k : 0u; } }
    unsigned T[R];
#pragma unroll
    for (int r = 0; r < R; ++r) T[r] = 0;
    for (int bit = 14; bit >= 0; --bit) {
        unsigned cnt[R];
#pragma unroll
        for (int r = 0; r < R; ++r) { const unsigned addc = (0x8000u - (T[r] | (1u << bit))) * 0x00010001u; unsigned c = 0, c1 = 0, c2 = 0, c3 = 0;
#pragma unroll
            for (int i = 0; i < NPK; i += 4) { c += (unsigned)__builtin_popcount((pk[r][i] + addc) & 0x80008000u); c1 += (unsigned)__builtin_popcount((pk[r][i + 1] + addc) & 0x80008000u); c2 += (unsigned)__builtin_popcount((pk[r][i + 2] + addc) & 0x80008000u); c3 += (unsigned)__builtin_popcount((pk[r][i + 3] + addc) & 0x80008000u); }
            cnt[r] = (c + c1) + (c2 + c3); }
#pragma unroll
        for (int r = 0; r < R; ++r) if (wave_total(cnt[r], 8) >= (unsigned)KSEL) T[r] |= 1u << bit;
    }
#pragma unroll
    for (int r = 0; r < R; ++r) {
        const unsigned c_gt = count_ge<NPK>(pk[r], T[r] + 1u);
        const unsigned c_ge = count_ge<NPK>(pk[r], T[r]);
        const int need = KSEL - (int)c_gt;
        const bool all_ties = (int)(c_ge - c_gt) == need;
        const unsigned addg = (0x7FFFu - T[r]) * 0x00010001u, adde = (0x8000u - T[r]) * 0x00010001u;
        int base = 0;
#pragma unroll
        for (int c = 0; c < NPK / 4; ++c) {
            if (512 * c < n) {
                const unsigned g0 = pk[r][4 * c] + addg, g1 = pk[r][4 * c + 1] + addg, g2 = pk[r][4 * c + 2] + addg, g3 = pk[r][4 * c + 3] + addg;
                const unsigned e0 = g0 ^ (pk[r][4 * c] + adde), e1 = g1 ^ (pk[r][4 * c + 1] + adde), e2 = g2 ^ (pk[r][4 * c + 2] + adde), e3 = g3 ^ (pk[r][4 * c + 3] + adde);
                unsigned zg = g3 & 0x80008000u; zg |= (g2 >> 2) & 0x20002000u; zg |= (g1 >> 4) & 0x08000800u; zg |= (g0 >> 6) & 0x02000200u; zg >>= 9;
                unsigned ze = e3 & 0x80008000u; ze |= (e2 >> 2) & 0x20002000u; ze |= (e1 >> 4) & 0x08000800u; ze |= (e0 >> 6) & 0x02000200u; ze >>= 9;
                const unsigned gtb = (zg | (zg >> 15)) & 0xFFu, eqb = (ze | (ze >> 15)) & 0xFFu;
                unsigned sel = gtb | eqb;
                if (!all_ties && __ballot(eqb != 0u) != 0ull) {
                    const unsigned ceq = (unsigned)__builtin_popcount(eqb); unsigned pre = 0, tot = 0;
#pragma unroll
                    for (int b = 0; b < 4; ++b) { const unsigned long long bal = __ballot((ceq >> b) & 1u);
                        pre += __builtin_amdgcn_mbcnt_hi((unsigned)(bal >> 32), __builtin_amdgcn_mbcnt_lo((unsigned)bal, 0u)) << b; tot += (unsigned)__builtin_popcountll(bal) << b; }
                    int k = need - base - (int)pre; unsigned take = 0;
#pragma unroll
                    for (int jb = 0; jb < 8; ++jb) { const bool e = (eqb >> jb) & 1u; if (e && k > 0) { take |= 1u << jb; --k; } }
                    sel = gtb | take; base += (int)tot;
                }
                if (512 * c + 8 * lane < n) mbase[r][(size_t)(8 * c + (lane >> 3)) * SEQ * 8 + (lane & 7)] = (unsigned char)sel;
            }
        }
    }
}
__device__ __forceinline__ void idx_select_phase(Frame& F, KArgs ap, int clo, int chi) {
    const unsigned short* SC = (const unsigned short*)(F.ws + WS_SC); unsigned char* MK = F.ws + WS_MASK;
    const int gw = F.vcu * NWAVES + F.wave, NGW = F.G * NWAVES, lane = F.lane;
    const KIn in{ap};
    const int per = (chi - clo + NGW - 1) / NGW, nsel = (SEQ + NGW - 1) / NGW, quota = (per + nsel - 1) / nsel;
    bool conv_turn = F.wave >= NWAVES / 2;
    int t = gw, k = 0;
    while (t < SEQ || k < per) {
        if ((conv_turn || t >= SEQ) && k < per) {
            for (int e = 0; e < quota && k < per; ++e, ++k) { const int id = clo + gw + NGW * k; if (id < chi) conv_one(in, F.ws, id, lane); }
        } else if (t < SEQ) {
            const int n = 64 * (t / 64 + 1);
            unsigned char* const mb[2] = {MK + (size_t)t * 8, MK + ((size_t)(SEQ / 64) * SEQ + t) * 8};
            const unsigned short* const sc[2] = {SC + (size_t)t * SEQ, SC + (size_t)(SEQ + t) * SEQ};
            if (n <= KSEL) { if (8 * lane < n) { mb[0][(size_t)(lane >> 3) * SEQ * 8 + (lane & 7)] = 0xFF; mb[1][(size_t)(lane >> 3) * SEQ * 8 + (lane & 7)] = 0xFF; } }
            else if (n <= 1024) select_rows<8, 2>(sc, n, lane, mb);
            else if (n <= 2048) select_rows<16, 2>(sc, n, lane, mb);
            else if (n <= 4096) select_rows<32, 2>(sc, n, lane, mb);
            else { const unsigned short* const s0[1] = {sc[0]}; unsigned char* const m0[1] = {mb[0]}; select_rows<64, 1>(s0, n, lane, m0);
                   const unsigned short* const s1[1] = {sc[1]}; unsigned char* const m1[1] = {mb[1]}; select_rows<64, 1>(s1, n, lane, m1); }
            t += NGW;
        }
        conv_turn = !conv_turn;
    }
}

__device__ __forceinline__ void moe_router_phase(Frame& F, const bf16* h, const float* wr  , const float* gain, gu32* cnt) {
    LAS float* wl = (LAS float*)(F.lds + RING_OFF);
    LAS unsigned* lcnt = (LAS unsigned*)(F.lds + RING_OFF + 32768);
    LAS unsigned* rec = (LAS unsigned*)(F.lds + RING_OFF + 32768 + 64);
    for (int i = F.tid; i < 1024 * 8; i += NWAVES * 64) wl[i] = wr[i] * gain[i >> 3];
    if (F.tid < 16) lcnt[F.tid] = 0u;
    __syncthreads();
    unsigned* TOK = (unsigned*)(F.ws + WS_TOK);
    for (int blk = F.vcu; blk < M / 64; blk += F.G) {
        for (int q = 0; q < 8; ++q) {
            const int tl = F.wave * 8 + q, t = blk * 64 + tl;
            const GAS v2u* xr = (const GAS v2u*)(h + (size_t)t * D) + F.lane;
            float acc[8] = {0.f, 0.f, 0.f, 0.f, 0.f, 0.f, 0.f, 0.f}; float ss = 0.f;
#pragma unroll
            for (int j = 0; j < 4; ++j) { const v2u xw = xr[64 * j]; const f32x4 v = {__uint_as_float(xw.x << 16), __uint_as_float(xw.x & 0xFFFF0000u), __uint_as_float(xw.y << 16), __uint_as_float(xw.y & 0xFFFF0000u)}; ss += (v.x * v.x + v.y * v.y) + (v.z * v.z + v.w * v.w);
#pragma unroll
                for (int c = 0; c < 4; ++c) { const LAS f32x4* wp = (const LAS f32x4*)(wl + (size_t)(256 * j + 4 * F.lane + c) * 8); const f32x4 w0 = wp[0], w1 = wp[1]; const float xv = v[c];
                    acc[0] += xv * w0[0]; acc[1] += xv * w0[1]; acc[2] += xv * w0[2]; acc[3] += xv * w0[3]; acc[4] += xv * w1[0]; acc[5] += xv * w1[1]; acc[6] += xv * w1[2]; acc[7] += xv * w1[3]; } }
            ss = wave_sum(ss); const float rstd = 1.0f / sqrtf(ss * (1.0f / D) + pg8::RMS_EPS_F);
            float lg[8];
#pragma unroll
            for (int e = 0; e < 8; ++e) lg[e] = wave_sum(acc[e]) * rstd;
            int e1 = 0; float l1 = lg[0];
#pragma unroll
            for (int e = 1; e < 8; ++e) if (lg[e] > l1) { l1 = lg[e]; e1 = e; }
            int e2 = -1; float l2 = -INFINITY;
#pragma unroll
            for (int e = 0; e < 8; ++e) if (e != e1 && lg[e] > l2) { l2 = lg[e]; e2 = e; }
            const float g1 = 1.0f / (1.0f + __expf(l2 - l1)), g2 = 1.0f - g1;
            if (F.lane == 0) { const unsigned s1 = atomicAdd((unsigned*)&lcnt[e1], 1u), s2 = atomicAdd((unsigned*)&lcnt[e2], 1u);
                LAS unsigned* rc = rec + tl * 8; rc[0] = (unsigned)e1; rc[1] = (unsigned)e2; rc[2] = s1; rc[3] = s2; rc[4] = __float_as_uint(g1); rc[5] = __float_as_uint(g2); rc[6] = __float_as_uint(rstd); rc[7] = 0u; }
        }
        __syncthreads();
        if (F.tid < 8) lcnt[8 + F.tid] = __hip_atomic_fetch_add(cnt + F.tid, lcnt[F.tid], __ATOMIC_RELAXED, __HIP_MEMORY_SCOPE_AGENT);
        __syncthreads();
        if (F.tid < 64) { const LAS unsigned* rc = rec + F.tid * 8; unsigned* o = TOK + (size_t)(blk * 64 + F.tid) * 8;
            const unsigned e1 = rc[0], e2 = rc[1];
            v4u a; a.x = e1; a.y = e2; a.z = rc[2] + lcnt[8 + e1]; a.w = rc[3] + lcnt[8 + e2]; v4u bq; bq.x = rc[4]; bq.y = rc[5]; bq.z = rc[6]; bq.w = 0u;
            *(v4u*)o = a; *(v4u*)(o + 4) = bq; }
        __syncthreads();
        if (F.tid < 16) lcnt[F.tid] = 0u;
        __syncthreads();
    }
}
__device__ __forceinline__ void moe_gather_phase(Frame& F, const gu32* cnt) {
    int rb[8]; { int acc = 0;
#pragma unroll
        for (int e = 0; e < 8; ++e) { rb[e] = acc * 256; acc += (int)((__builtin_amdgcn_readfirstlane(__hip_atomic_load(cnt + e, RLX_AGENT)) + 255u) >> 8); } }
    unsigned* TOK = (unsigned*)(F.ws + WS_TOK); const unsigned char* HB8 = F.ws + WS_HB8; unsigned char* AS = F.ws + WS_ASORT;
    float* RSD = (float*)(F.ws + WS_RSD); float* GATE = (float*)(F.ws + WS_GATE);
    const int gw = F.vcu * NWAVES + F.wave, NGW = F.G * NWAVES;
    for (int t0 = gw; t0 < M; t0 += 4 * NGW) {
        v4u a[4], bq[4], v0[4];
#pragma unroll
        for (int q = 0; q < 4; ++q) { const int t = t0 + q * NGW; a[q] = *(const v4u*)(TOK + (size_t)t * 8); bq[q] = *(const v4u*)(TOK + (size_t)t * 8 + 4); v0[q] = ((const GAS v4u*)(HB8 + (size_t)t * D))[F.lane]; }
#pragma unroll
        for (int q = 0; q < 4; ++q) { const int t = t0 + q * NGW;
            int r1 = (int)a[q].z, r2 = (int)a[q].w;
#pragma unroll
            for (int e = 0; e < 8; ++e) { r1 += ((int)a[q].x == e) ? rb[e] : 0; r2 += ((int)a[q].y == e) ? rb[e] : 0; }
            ((GAS v4u*)(AS + (size_t)r1 * D))[F.lane] = v0[q]; ((GAS v4u*)(AS + (size_t)r2 * D))[F.lane] = v0[q];
            if (F.lane == 0) { RSD[r1] = __uint_as_float(bq[q].z); RSD[r2] = __uint_as_float(bq[q].z); GATE[r1] = __uint_as_float(bq[q].x); GATE[r2] = __uint_as_float(bq[q].y);
                v2u rr; rr.x = (unsigned)r1; rr.y = (unsigned)r2; *(v2u*)(TOK + (size_t)t * 8 + 2) = rr; } }
    }
}
template <bool FINAL> __device__ __forceinline__ void moe_combine_phase(Frame& F, const bf16* hin, float* out_f32, bf16* hs, const float* fgain) {
    const unsigned* TOK = (const unsigned*)(F.ws + WS_TOK); const bf16* Y = (const bf16*)(F.ws + WS_Y); unsigned char* HB8 = F.ws + WS_HB8; float* ssq = (float*)(F.ws + WS_SSQ);
    const int gw = F.vcu * NWAVES + F.wave, NGW = F.G * NWAVES;
    for (int t0 = gw; t0 < M; t0 += 2 * NGW) {
        v2u rr[2]; v2u hw[2][4], ya[2][4], yb[2][4];
#pragma unroll
        for (int q = 0; q < 2; ++q) rr[q] = *(const v2u*)(TOK + (size_t)(t0 + q * NGW) * 8 + 2);
#pragma unroll
        for (int q = 0; q < 2; ++q) { const int t = t0 + q * NGW; const GAS v2u* hi_ = (const GAS v2u*)(hin + (size_t)t * D) + F.lane;
            const GAS v2u* y1 = (const GAS v2u*)(Y + (size_t)rr[q].x * D) + F.lane; const GAS v2u* y2 = (const GAS v2u*)(Y + (size_t)rr[q].y * D) + F.lane;
#pragma unroll
            for (int j = 0; j < 4; ++j) { hw[q][j] = hi_[64 * j]; ya[q][j] = y1[64 * j]; yb[q][j] = y2[64 * j]; } }
#pragma unroll
        for (int q = 0; q < 2; ++q) { const int t = t0 + q * NGW; float s = 0.f; f32x4 v[4];
#pragma unroll
            for (int j = 0; j < 4; ++j) { const v2u a = ya[q][j], bq = yb[q][j], hh = hw[q][j]; f32x4& w = v[j];
                w.x = __uint_as_float(hh.x << 16) + (__uint_as_float(a.x << 16) + __uint_as_float(bq.x << 16)); w.y = __uint_as_float(hh.x & 0xFFFF0000u) + (__uint_as_float(a.x & 0xFFFF0000u) + __uint_as_float(bq.x & 0xFFFF0000u));
                w.z = __uint_as_float(hh.y << 16) + (__uint_as_float(a.y << 16) + __uint_as_float(bq.y << 16)); w.w = __uint_as_float(hh.y & 0xFFFF0000u) + (__uint_as_float(a.y & 0xFFFF0000u) + __uint_as_float(bq.y & 0xFFFF0000u));
                s += (w.x * w.x + w.y * w.y) + (w.z * w.z + w.w * w.w); }
            s = wave_sum(s);
            if (FINAL) { const float rstd = 1.0f / sqrtf(s * (1.0f / D) + pg8::RMS_EPS_F); GAS f32x4* hr = (GAS f32x4*)(out_f32 + (size_t)t * D) + F.lane;
#pragma unroll
                for (int j = 0; j < 4; ++j) { const f32x4 g = ((const GAS f32x4*)fgain)[64 * j + F.lane]; hr[64 * j] = v[j] * rstd * g; } }
            else { GAS unsigned* o4 = (GAS unsigned*)(HB8 + (size_t)t * D) + F.lane; GAS v2u* o8 = (GAS v2u*)(hs + (size_t)t * D) + F.lane;
#pragma unroll
                for (int j = 0; j < 4; ++j) { v2u w; w.x = pkbf(v[j].x, v[j].y); w.y = pkbf(v[j].z, v[j].w); o8[64 * j] = w; o4[64 * j] = pg8::pk4f8(v[j].x, v[j].y, v[j].z, v[j].w); }
                if (F.lane < 16) ssq[(size_t)t * 16 + F.lane] = F.lane == 0 ? s : 0.f; } }
    }
}
__device__ __forceinline__ void fox_scan_phase(Frame& F) {
    const float* LOGF = (const float*)(F.ws + WS_LOGF); float* GK = (float*)(F.ws + WS_GK);
    LAS float* part = (LAS float*)(F.lds + RING_OFF);
    for (int bh = F.vcu; bh < BATCH * NH; bh += F.G) {
        const int b = bh / NH, hh = bh % NH; float v[16]; float run = 0.f;
#pragma unroll
        for (int k = 0; k < 16; ++k) { run += LOGF[(size_t)(b * SEQ + F.tid * 16 + k) * 16 + hh]; v[k] = run; }
        float incl = run;
#pragma unroll
        for (int o = 1; o < 64; o <<= 1) { const float up = __shfl_up(incl, o); if (F.lane >= o) incl += up; }
        if (F.lane == 63) part[F.wave] = incl;
        __syncthreads();
        float off = incl - run;
        for (int w = 0; w < F.wave; ++w) off += part[w];
#pragma unroll
        for (int k = 0; k < 16; ++k) GK[(size_t)bh * SEQ + F.tid * 16 + k] = -(off + v[k]) * LOG2E;
        __syncthreads();
    }
}

__device__ __forceinline__ Frame make_frame(unsigned char* lds_generic, KArgs ap, const int wv) {
    Frame F; F.lds = (LAS unsigned char*)lds_generic; F.MISC = (volatile LAS unsigned*)(F.lds + MISC_OFF);
    F.lane = lane_id_v(); F.wave = wv; F.tid = wv * 64 + F.lane;
    F.G = gridDim.x; { const int bx = blockIdx.x; F.vcu = (F.G % 8 == 0) ? (bx % 8) * (F.G / 8) + bx / 8 : bx; }
    F.ws = (unsigned char*)ap->ws; F.ctl = (gu32*)(F.ws + WS_CTL); F.dry = ap->pad;
    return F;
}
__device__ __forceinline__ void phase_barrier(unsigned char* lds_generic, KArgs ap, const int wv) {
    XcdBarrier bar; bar.bar = (unsigned*)((unsigned char*)ap->ws + WS_CTL) + CW_BAR + ap->li * XCD_BAR_WORDS; bar.x = xb_xcc_id(); bar.st = (volatile LAS unsigned*)((LAS unsigned char*)lds_generic + MISC_OFF) + 8;
    xcd_barrier(bar, wv == 0 && lane_id_v() == 0);
}
#ifndef MK_PROBE
#define MK_PROBE 0
#endif
#ifndef PA0
#define PA0 0
#define PA1 32
#define PB0 0
#define PB1 1
#define PB_SCALE 20.0f
#endif
#if MK_PROBE
#define STAMP(k) do { if (blockIdx.x == 0 && wv == 0 && lane_id_v() == 0) ((volatile LAS unsigned*)(size_t)(LDSCTL_OFF + 1024))[k] = (unsigned)__builtin_amdgcn_s_memrealtime(); } while (0)
#else
#define STAMP(k) do {} while (0)
#endif
#define PHASE_BEGIN(k) if (ap->ph_lo <= (k) && (k) < ap->ph_hi) { STAMP(k); Frame F = make_frame(lds_generic, ap, wv);
#define PHASE_END(k)   if (MK_ONE_LAUNCH && (k) + 1 < ap->ph_hi) phase_barrier(lds_generic, ap, wv); }
template <int L> __device__ __forceinline__ void layer(KArgs ap, unsigned char* lds_generic, const int wv) {
    constexpr int P = (L == 0) ? 1 : (L == 1) ? 8 : (L == 2) ? 18 : 24;
#define ws (F.ws)
#define hout ((float*)ap->out)
#define HB ((bf16*)(ws + WS_HB))
#define SSQ ((float*)(ws + WS_SSQ))
#define Qb ((bf16*)(ws + WS_Q))
#define Kb ((bf16*)(ws + WS_K))
#define Vb ((bf16*)(ws + WS_V))
#define Ob ((bf16*)(ws + WS_O))
#define H2 ((bf16*)(ws + WS_H2))
#define cosT ((const float*)(ws + WS_COS))
#define sinT ((const float*)(ws + WS_SIN))
    constexpr int PO = (L < 2) ? P + 4 : (L == 2 ? P + 3 : P + 2);
    if constexpr (L < 2) {
        PHASE_BEGIN(P) {
            { pg8::Gemm g{(const bf16*)(ws + WS_HB8), (const bf16*)(ws + W_AIN + L * W_AIN_SZ), M, 3 * D, D / 2}; pg8::StaticOrder S; S.init(M, 3 * D, F.G, (int)blockIdx.x);
              pg8::EpiAin E{Qb, Kb, Vb, (bf16*)(ws + WS_QI), (bf16*)(ws + WS_KI), (float*)(ws + WS_WI), SSQ, cosT, sinT, C2, 1.0f / IN_PRESCALE, 0};
              pg8::gemm_phase<pg8::EpiAin, pg8::StaticOrder, true, true, 1>(F.lds + RING_OFF, g, S, E, wv); }
            { pg8::Gemm g{HB, (const bf16*)(ws + W_AIN + L * W_AIN_SZ + W_AINX_OFF), M, AIN_NP - 3 * D, D}; pg8::StaticOrder S; S.init(M, AIN_NP - 3 * D, F.G, (int)blockIdx.x);
              pg8::EpiAin E{Qb, Kb, Vb, (bf16*)(ws + WS_QI), (bf16*)(ws + WS_KI), (float*)(ws + WS_WI), SSQ, cosT, sinT, C2, 1.0f, 12};
              pg8::gemm_phase<pg8::EpiAin, pg8::StaticOrder, true, true, 0>(F.lds + RING_OFF, g, S, E, wv); }
        } PHASE_END(P)
        PHASE_BEGIN(P + 1) idx_scores_phase(F); PHASE_END(P + 1)
        PHASE_BEGIN(P + 2) idx_select_phase(F, ap, L == 0 ? CV_SEG0 : CV_SEG1, L == 0 ? CV_SEG1 : CV_SEG2); PHASE_END(P + 2)
        PHASE_BEGIN(P + 3) {
            const attn_body::AttnTensors AT{(const attn_body::bf16*)Qb, (const attn_body::bf16*)Kb, (const attn_body::bf16*)Vb, (attn_body::bf16*)Ob, nullptr, (const unsigned long long*)(ws + WS_MASK)};
            const attn_body::StaticOrder S((int)F.G, (int)blockIdx.x);
            attn_body::attn_phase<1, attn_body::StaticOrder>((char*)lds_generic + RING_OFF, AT, S, wv);
        } PHASE_END(P + 3)
    } else {
        PHASE_BEGIN(P) {
            constexpr int NP = (L == 2) ? KVQ_NP : D;
            pg8::Gemm g{(const bf16*)(ws + WS_HB8), (const bf16*)(ws + (L == 2 ? W_KVQ : W_BQ3)), M, NP, D / 2}; pg8::StaticOrder S; S.init(M, NP, F.G, (int)blockIdx.x);
            pg8::EpiKVQ E{Qb, (size_t)(WS_K - WS_Q) / 2, (float*)(ws + WS_LOGF), (const float*)ap->in[I_BF], SSQ, C2, 1.0f / IN_PRESCALE};
            pg8::gemm_phase<pg8::EpiKVQ, pg8::StaticOrder, true, true, 1>(F.lds + RING_OFF, g, S, E, wv);
        } PHASE_END(P)
        if constexpr (L == 2) { PHASE_BEGIN(P + 1) fox_scan_phase(F); PHASE_END(P + 1) }
        PHASE_BEGIN(PO - 1) {
            const attn_body::AttnTensors AT{(const attn_body::bf16*)Qb, (const attn_body::bf16*)Kb, (const attn_body::bf16*)Vb, (attn_body::bf16*)Ob, (const float*)(ws + WS_GK), nullptr};
            attn_body::attn_phase_queue<0>((char*)lds_generic + RING_OFF, AT, (unsigned*)(F.ctl + CW_AQ + 64 * (L - 2) + 16 * ap->li), (volatile LAS unsigned*)(F.lds + LDSCTL_OFF + 3072), wv, F.tid == 0);
        } PHASE_END(PO - 1)
    }
    PHASE_BEGIN(PO) {
        const bf16* Wo = (const bf16*)(ws + (L < 2 ? W_AOUT + L * W_SQ_SZ : W_BOUT + (L - 2) * W_SQ_SZ));
        pg8::Gemm g{Ob, Wo, M, D, D / 2}; pg8::StaticOrder S; S.init(M, D, F.G, (int)blockIdx.x);
        pg8::EpiRes<L == 0> E{(L == 0) ? (const void*)ap->in[I_X] : (const void*)HB, H2, ws + WS_HB8, SSQ, 1.0f / OUT_PRESCALE};
        pg8::gemm_phase<pg8::EpiRes<L == 0>, pg8::StaticOrder, true, true, 1>(F.lds + RING_OFF, g, S, E, wv);
    } PHASE_END(PO)
    if constexpr ((L & 1) == 0) {
        PHASE_BEGIN(PO + 1) {
            pg8::Gemm g{(const bf16*)(ws + WS_HB8), (const bf16*)(ws + W_DGU + (L >> 1) * W_GU8_SZ), M, 2 * DFF, D / 2}; pg8::StaticOrder S; S.init(M, 2 * DFF, F.G, (int)blockIdx.x);
            pg8::EpiSwiglu E{ws + WS_ACT, SSQ, nullptr, 2 * DFF / 256, 1.0f / GU_PRESCALE, F.dry};
            pg8::gemm_phase<pg8::EpiSwiglu, pg8::StaticOrder, true, true, 1>(F.lds + RING_OFF, g, S, E, wv);
        } PHASE_END(PO + 1)
        PHASE_BEGIN(PO + 2) {
            pg8::Gemm g{(const bf16*)(ws + WS_ACT), (const bf16*)(ws + W_DDN + (L >> 1) * W_DN8_SZ), M, D, DFF / 2}; pg8::StaticOrder S; S.init(M, D, F.G, (int)blockIdx.x);
            pg8::EpiRes<false> E{(const void*)H2, HB, ws + WS_HB8, SSQ, 1.0f / DN_PRESCALE};
            pg8::gemm_phase<pg8::EpiRes<false>, pg8::StaticOrder, true, true, 1>(F.lds + RING_OFF, g, S, E, wv);
        } PHASE_END(PO + 2)
    } else {
#define cnt (F.ctl + CW_CNT + 64 * (L >> 1))
        PHASE_BEGIN(PO + 1) moe_router_phase(F, H2, (const float*)ap->in[I_ROUTER] + (size_t)(L >> 1) * D * NEXP, (const float*)ap->in[I_FFNNORM] + L * D, cnt); PHASE_END(PO + 1)
        PHASE_BEGIN(PO + 2) moe_gather_phase(F, cnt); PHASE_END(PO + 2)
        PHASE_BEGIN(PO + 3) {
            pg8::Gemm g{(const bf16*)(ws + WS_ASORT), (const bf16*)(ws + W_MGU + (size_t)(L >> 1) * 8 * W_GU8_SZ), SORT_ROWS, 2 * DFF, D / 2};
            pg8::GroupedOrder S; S.init((const unsigned*)cnt, 2 * DFF / 256, F.G, (int)blockIdx.x, (LAS int*)(F.lds + LDSCTL_OFF + 2048), F.tid == 0);
            pg8::EpiSwiglu E{ws + WS_ACT, nullptr, (const float*)(ws + WS_RSD), 2 * DFF / 256, 1.0f / GU_PRESCALE, F.dry};
            pg8::gemm_phase<pg8::EpiSwiglu, pg8::GroupedOrder, true, true, 1>(F.lds + RING_OFF, g, S, E, wv);
        } PHASE_END(PO + 3)
        PHASE_BEGIN(PO + 4) {
            pg8::Gemm g{(const bf16*)(ws + WS_ACT), (const bf16*)(ws + W_MDN + (size_t)(L >> 1) * 8 * W_DN8_SZ), SORT_ROWS, D, DFF / 2};
            pg8::GroupedOrder S; S.init((const unsigned*)cnt, D / 256, F.G, (int)blockIdx.x, (LAS int*)(F.lds + LDSCTL_OFF + 2048), F.tid == 0);
            pg8::EpiMoeDown E{(bf16*)(ws + WS_Y), (const float*)(ws + WS_GATE), 1.0f / DN_PRESCALE};
            pg8::gemm_phase<pg8::EpiMoeDown, pg8::GroupedOrder, true, true, 1>(F.lds + RING_OFF, g, S, E, wv);
        } PHASE_END(PO + 4)
        PHASE_BEGIN(PO + 5) { if constexpr (L == 3) moe_combine_phase<true>(F, H2, hout, nullptr, (const float*)ap->in[I_FNORM]); else moe_combine_phase<false>(F, H2, nullptr, HB, nullptr); } PHASE_END(PO + 5)
    }
#undef ws
#undef hout
#undef HB
#undef SSQ
#undef Qb
#undef Kb
#undef Vb
#undef Ob
#undef H2
#undef cosT
#undef sinT
#undef cnt
}
__global__ void __launch_bounds__(NWAVES * 64, 2) yoco_fwd(Args args_unused) {
    extern __shared__ __attribute__((aligned(16))) unsigned char lds[];
    KArgs ap = (KArgs)__builtin_amdgcn_kernarg_segment_ptr();
    unsigned char* lds_generic = lds;
    const int wv = __builtin_amdgcn_readfirstlane(threadIdx.x >> 6);
    {
        LAS unsigned char* l3 = (LAS unsigned char*)lds;
        for (int u = threadIdx.x; u < (LDS_BYTES - LDSCTL_OFF) / 4; u += NWAVES * 64) ((LAS unsigned*)(l3 + LDSCTL_OFF))[u] = 0u;
        __syncthreads();
        if (MK_ONE_LAUNCH) (void)xcd_barrier_post((unsigned*)((unsigned char*)ap->ws + WS_CTL) + CW_BAR + ap->li * XCD_BAR_WORDS, (volatile LAS unsigned*)(l3 + MISC_OFF) + 8, threadIdx.x == 0);
    }
    PHASE_BEGIN(0) p0_prologue(F, ap); PHASE_END(0)
    layer<0>(ap, lds_generic, wv);
#if defined(MK_EXTRA_BAR)
    for (int xb_ = 0; xb_ < MK_EXTRA_BAR; ++xb_) phase_barrier(lds_generic, ap, wv);
#endif
    layer<1>(ap, lds_generic, wv);
    layer<2>(ap, lds_generic, wv);
    layer<3>(ap, lds_generic, wv);
#if MK_PROBE
    phase_barrier(lds_generic, ap, wv); STAMP(32);
    if (blockIdx.x == 0) {
        __syncthreads();
        volatile LAS unsigned* st = (volatile LAS unsigned*)(size_t)(LDSCTL_OFF + 1024);
        float a_us = (float)(st[PA1] - st[PA0]) * 0.01f, b_val = (float)(st[PB1] - st[PB0]) * 0.01f; a_us = __builtin_amdgcn_exp2f(__builtin_rintf(__builtin_amdgcn_logf(a_us) * 6.0f) * (1.0f / 6.0f)); b_val = __builtin_amdgcn_exp2f(__builtin_rintf(__builtin_amdgcn_logf(b_val) * 6.0f) * (1.0f / 6.0f)) / PB_SCALE;
        float* o = (float*)ap->out;
        for (int i = wv * 64 + lane_id_v(); i < 1024 * 1024; i += NWAVES * 64) o[1024 + i] = b_val;
        if (wv == 0 && lane_id_v() == 0) o[0] = a_us;
    }
#endif
}
#undef PHASE_BEGIN
#undef PHASE_END
constexpr int N_PHASES = 1 + (4 + 1 + 2) + (4 + 1 + 5) + (3 + 1 + 2) + (2 + 1 + 5);

extern "C" void kernel_launch(void* const* d_in, const int* in_sizes, int n_in, void* d_out, int out_size, void* d_ws, size_t ws_size, hipStream_t stream) {
    static int grid = 0;
    if (grid == 0) {
        if (n_in != 17 || in_sizes[0] != M * D || out_size != M * D || ws_size < WS_END) { fprintf(stderr, "kernel_launch: unexpected shapes (n_in %d, in0 %d, out %d, ws %zu < %zu); nothing launched\n", n_in, n_in > 0 ? in_sizes[0] : -1, out_size, ws_size, (size_t)WS_END); grid = -1; return; }
        int dev = 0, cus = 0, per_cu = 0;
        if (hipGetDevice(&dev) != hipSuccess || hipDeviceGetAttribute(&cus, hipDeviceAttributeMultiprocessorCount, dev) != hipSuccess) { grid = -1; return; }
        if (hipFuncSetAttribute((const void*)yoco_fwd, hipFuncAttributeMaxDynamicSharedMemorySize, LDS_BYTES) != hipSuccess) { fprintf(stderr, "kernel_launch: hipFuncSetAttribute failed\n"); grid = -1; return; }
        if (hipOccupancyMaxActiveBlocksPerMultiprocessor(&per_cu, (const void*)yoco_fwd, NWAVES * 64, LDS_BYTES) != hipSuccess || per_cu < 1) { fprintf(stderr, "kernel_launch: occupancy query reports %d workgroups per CU\n", per_cu); }
        (void)hipGetLastError();
        grid = cus;
    }
    if (grid < 0) return;
    if (hipMemsetAsync((char*)d_ws + WS_CTL, 0, CTL_ZERO_BYTES, stream) != hipSuccess) return;
    Args a{};
    for (int i = 0; i < 17; ++i) a.in[i] = (const float*)d_in[i];
    a.out = (float*)d_out; a.ws = (unsigned char*)d_ws;
#if defined(MK_RERUN_LO)
#ifndef MK_RERUN_DRY
#define MK_RERUN_DRY 0
#endif
#ifndef MK_RERUN_REP
#define MK_RERUN_REP 1
#endif
    { const int cuts[4][2] = {{0, MK_RERUN_HI}, {MK_RERUN_LO, MK_RERUN_HI}, {MK_RERUN_HI, N_PHASES}, {0, 0}};
      for (int li = 0; li < 3; ++li) { if (cuts[li][0] >= cuts[li][1]) continue; a.ph_lo = cuts[li][0]; a.ph_hi = cuts[li][1]; a.li = li; a.pad = (li == 1) ? MK_RERUN_DRY : 0; for (int rep = 0; rep < ((li == 1) ? MK_RERUN_REP : 1); ++rep) hipLaunchKernelGGL(yoco_fwd, dim3(grid), dim3(NWAVES * 64), LDS_BYTES, stream, a); } }
#elif MK_ONE_LAUNCH
    a.ph_lo = 0; a.ph_hi = N_PHASES;
    hipLaunchKernelGGL(yoco_fwd, dim3(grid), dim3(NWAVES * 64), LDS_BYTES, stream, a);
#else
    for (int p = 0; p < N_PHASES; ++p) { a.ph_lo = p; a.ph_hi = p + 1; hipLaunchKernelGGL(yoco_fwd, dim3(grid), dim3(NWAVES * 64), LDS_BYTES, stream, a); }
#endif
}
```
